# Optimizing an MI355X kernel written in HIP

```python
import math
import jax, jax.numpy as jnp
from jax import lax
import numpy as np

D_MODEL = 1024
BATCH = 8
SEQ = 8192
DEPTH = 4

N_MIXERS = 2
BRANCH = D_MODEL
SSM_GROUP = 16
SSM_GROUPS = BRANCH // SSM_GROUP
SSM_STATE = 64
SSM_CHUNK = 128
DT_MIN = 1e-3
DT_MAX = 1e-1
HEAD_DIM = 64
N_Q_HEADS = BRANCH // HEAD_DIM
N_KV_HEADS = 2
GQA_GROUP = N_Q_HEADS // N_KV_HEADS
WINDOW = 128
ATTN_BLOCK = 128
Q_DIM = N_Q_HEADS * HEAD_DIM
KV_DIM = N_KV_HEADS * HEAD_DIM
ROPE_THETA = 10000.0
NORM_EPS = 1e-5
NEG_INF = -1e30

kernel_name = "hybrid_s5_swa_sink_trunk"


def _rmsnorm(x, g):
    xf = x.astype(jnp.float32)
    y = xf * lax.rsqrt(jnp.mean(xf * xf, axis=-1, keepdims=True) + NORM_EPS)
    return (y * g.astype(jnp.float32)).astype(x.dtype)


def _ssm_combine(e1, e2):
    a1, b1 = e1
    a2, b2 = e2
    return a1 * a2, a2 * b1 + b2


def _s5_scan(u, a_re, a_im, log_step, b_re, b_im, c_re, c_im, d):
    bsz, seq, _ = u.shape
    f32 = jnp.float32
    u = u.astype(f32)
    lam = lax.complex(a_re.astype(f32), a_im.astype(f32))
    step = jnp.exp(log_step.astype(f32))[:, None]
    a_bar = jnp.exp(lam * step)
    b = lax.complex(b_re.astype(f32), b_im.astype(f32))
    b_bar = ((a_bar - 1.0) / lam)[..., None] * b
    c = lax.complex(c_re.astype(f32), c_im.astype(f32))
    n_chunks = seq // SSM_CHUNK
    u_c = u.reshape(bsz, n_chunks, SSM_CHUNK, SSM_GROUPS, SSM_GROUP).transpose(1, 2, 0, 3, 4)

    def step_fn(h_prev, u_blk):
        bu = jnp.einsum("tbgc,gpc->tbgp", u_blk.astype(b_bar.dtype), b_bar)
        a = jnp.broadcast_to(a_bar, bu.shape)
        a_cum, h_loc = lax.associative_scan(_ssm_combine, (a, bu), axis=0)
        h = h_loc + a_cum * h_prev[None]
        y = jnp.real(jnp.einsum("tbgp,gcp->tbgc", h, c))
        return h[-1], y

    h0 = jnp.zeros((bsz, SSM_GROUPS, SSM_STATE), dtype=b_bar.dtype)
    _, y = lax.scan(step_fn, h0, u_c)
    y = y.transpose(2, 0, 1, 3, 4).reshape(bsz, seq, BRANCH)
    return y + d.astype(f32) * u


def _ssm_layer(x, norm, w_in, a_re, a_im, log_step, b_re, b_im, c_re, c_im, d, w_glu, b_glu, w_out):
    f32 = jnp.float32
    h = _rmsnorm(x, norm)
    proj = h @ w_in
    u, gate = jnp.split(proj, [BRANCH], axis=-1)
    y = _s5_scan(u, a_re, a_im, log_step, b_re, b_im, c_re, c_im, d)
    z = jax.nn.gelu(y)
    z = z * jax.nn.sigmoid(z @ w_glu.astype(f32) + b_glu.astype(f32))
    out = (z * jax.nn.silu(gate.astype(f32))).astype(x.dtype) @ w_out
    return x + out


def _rope(t, cos, sin):
    t1, t2 = jnp.split(t, 2, axis=-1)
    return jnp.concatenate([t1 * cos - t2 * sin, t2 * cos + t1 * sin], axis=-1)


def _swa_sinks(q, k, v, sinks):
    f32 = jnp.float32
    bsz, seq = q.shape[:2]
    nb = seq // ATTN_BLOCK
    qb = q.reshape(bsz, nb, ATTN_BLOCK, N_KV_HEADS, GQA_GROUP, HEAD_DIM)
    kb = k.reshape(bsz, nb, ATTN_BLOCK, N_KV_HEADS, HEAD_DIM)
    vb = v.reshape(bsz, nb, ATTN_BLOCK, N_KV_HEADS, HEAD_DIM)

    def with_prev(t):
        prev = jnp.concatenate([jnp.zeros_like(t[:, :1]), t[:, :-1]], axis=1)
        return jnp.concatenate([prev, t], axis=2)

    kk = with_prev(kb)
    vv = with_prev(vb)
    s = jnp.einsum("bnqhgd,bnkhd->bnhgqk", qb, kk) * (HEAD_DIM ** -0.5)
    qi = jnp.arange(ATTN_BLOCK)[:, None]
    kj = jnp.arange(2 * ATTN_BLOCK)[None, :]
    dist = qi + ATTN_BLOCK - kj
    band = (dist >= 0) & (dist < WINDOW)
    blk = jnp.arange(nb)[:, None, None]
    valid = band[None] & ((blk > 0) | (kj[None] >= ATTN_BLOCK))
    s = jnp.where(valid[None, :, None, None], s, NEG_INF)
    sink = sinks.astype(f32).reshape(N_KV_HEADS, GQA_GROUP)[None, None, :, :, None, None]
    m = jnp.maximum(jnp.max(s, axis=-1, keepdims=True), sink)
    p = jnp.exp(s - m)
    denom = jnp.sum(p, axis=-1, keepdims=True) + jnp.exp(sink - m)
    o = jnp.einsum("bnhgqk,bnkhd->bnqhgd", p / denom, vv)
    return o.reshape(bsz, seq, Q_DIM)


def _attn_layer(x, norm, w_in, sinks, w_out):
    f32 = jnp.float32
    bsz, seq, _ = x.shape
    h = _rmsnorm(x, norm)
    proj = (h @ w_in).astype(f32)
    q, k, v, gate = jnp.split(proj, [Q_DIM, Q_DIM + KV_DIM, Q_DIM + 2 * KV_DIM], axis=-1)
    q = q.reshape(bsz, seq, N_Q_HEADS, HEAD_DIM)
    k = k.reshape(bsz, seq, N_KV_HEADS, HEAD_DIM)
    v = v.reshape(bsz, seq, N_KV_HEADS, HEAD_DIM)
    pos = jnp.arange(seq, dtype=f32)
    inv_freq = ROPE_THETA ** (-jnp.arange(0, HEAD_DIM, 2, dtype=f32) / HEAD_DIM)
    ang = pos[:, None] * inv_freq[None, :]
    cos = jnp.cos(ang)[None, :, None, :]
    sin = jnp.sin(ang)[None, :, None, :]
    o = _swa_sinks(_rope(q, cos, sin), _rope(k, cos, sin), v, sinks)
    out = (o * jax.nn.silu(gate)).astype(x.dtype) @ w_out
    return x + out


def setup_inputs(seed: int = 0) -> dict:
    key = jax.random.key(seed)
    keys = iter(jax.random.split(key, 64))
    f32 = jnp.float32

    def nrm(shape, scale):
        return jax.random.normal(next(keys), shape, f32) * scale

    inputs = {"x": nrm((BATCH, SEQ, D_MODEL), 1.0)}
    for i in range(DEPTH):
        p = "l%d_" % i
        inputs[p + "norm"] = 1.0 + nrm((D_MODEL,), 0.05)
        if i % N_MIXERS == 0:
            inputs[p + "w_in"] = nrm((D_MODEL, 2 * BRANCH), D_MODEL ** -0.5)
            inputs[p + "a_re"] = -0.5 + nrm((SSM_GROUPS, SSM_STATE), 0.01)
            inputs[p + "a_im"] = math.pi * jnp.arange(SSM_STATE, dtype=f32)[None, :] + nrm((SSM_GROUPS, SSM_STATE), 0.01)
            inputs[p + "log_step"] = jax.random.uniform(next(keys), (SSM_GROUPS,), f32, math.log(DT_MIN), math.log(DT_MAX))
            inputs[p + "b_re"] = nrm((SSM_GROUPS, SSM_STATE, SSM_GROUP), (2 * SSM_GROUP) ** -0.5)
            inputs[p + "b_im"] = nrm((SSM_GROUPS, SSM_STATE, SSM_GROUP), (2 * SSM_GROUP) ** -0.5)
            inputs[p + "c_re"] = nrm((SSM_GROUPS, SSM_GROUP, SSM_STATE), SSM_STATE ** -0.5)
            inputs[p + "c_im"] = nrm((SSM_GROUPS, SSM_GROUP, SSM_STATE), SSM_STATE ** -0.5)
            inputs[p + "d"] = nrm((BRANCH,), 1.0)
            inputs[p + "w_glu"] = nrm((BRANCH, BRANCH), BRANCH ** -0.5)
            inputs[p + "b_glu"] = nrm((BRANCH,), 0.01)
            inputs[p + "w_out"] = nrm((BRANCH, D_MODEL), BRANCH ** -0.5)
        else:
            inputs[p + "w_in"] = nrm((D_MODEL, Q_DIM + 2 * KV_DIM + BRANCH), D_MODEL ** -0.5)
            inputs[p + "sinks"] = nrm((N_Q_HEADS,), 1.0)
            inputs[p + "w_out"] = nrm((Q_DIM, D_MODEL), Q_DIM ** -0.5)
    inputs["final_norm"] = 1.0 + nrm((D_MODEL,), 0.05)
    return inputs


def reference(x,
              l0_norm, l0_w_in, l0_a_re, l0_a_im, l0_log_step, l0_b_re, l0_b_im, l0_c_re, l0_c_im, l0_d, l0_w_glu, l0_b_glu, l0_w_out,
              l1_norm, l1_w_in, l1_sinks, l1_w_out,
              l2_norm, l2_w_in, l2_a_re, l2_a_im, l2_log_step, l2_b_re, l2_b_im, l2_c_re, l2_c_im, l2_d, l2_w_glu, l2_b_glu, l2_w_out,
              l3_norm, l3_w_in, l3_sinks, l3_w_out,
              final_norm):
    ssm_params = [
        (l0_norm, l0_w_in, l0_a_re, l0_a_im, l0_log_step, l0_b_re, l0_b_im, l0_c_re, l0_c_im, l0_d, l0_w_glu, l0_b_glu, l0_w_out),
        (l2_norm, l2_w_in, l2_a_re, l2_a_im, l2_log_step, l2_b_re, l2_b_im, l2_c_re, l2_c_im, l2_d, l2_w_glu, l2_b_glu, l2_w_out),
    ]
    attn_params = [
        (l1_norm, l1_w_in, l1_sinks, l1_w_out),
        (l3_norm, l3_w_in, l3_sinks, l3_w_out),
    ]
    for i in range(DEPTH):
        if i % N_MIXERS == 0:
            x = _ssm_layer(x, *ssm_params[i // N_MIXERS])
        else:
            x = _attn_layer(x, *attn_params[i // N_MIXERS])
    return _rmsnorm(x, final_norm)
```

```cpp
#include <hip/hip_runtime.h>
#include <hip/hip_cooperative_groups.h>
#include <cstdint>
#include <cstdio>
namespace cg = cooperative_groups;

#define LAS __attribute__((address_space(3)))
typedef _Float16 h16;
typedef _Float16 h8 __attribute__((ext_vector_type(8)));
typedef _Float16 h4 __attribute__((ext_vector_type(4)));
typedef float f32x4 __attribute__((ext_vector_type(4)));
typedef float f32x2 __attribute__((ext_vector_type(2)));
typedef float f32x16 __attribute__((ext_vector_type(16)));

constexpr int M_TOK = 65536, DM = 1024, SEQ = 8192;
constexpr int ROWS_G = 4096;
constexpr int UHK = 384;
constexpr float NORM_EPS = 1e-5f;
constexpr float LOG2E = 1.4426950408889634f;

constexpr size_t MiB = 1u << 20;
constexpr size_t WS_SUMSQ = 0;
constexpr size_t WS_ROPE  = 2 * MiB;
constexpr size_t WS_A16   = 4 * MiB;
constexpr size_t WS_ASEG  = 4 * MiB + 65536;
constexpr size_t WS_STEP  = 4 * MiB + 131072;
constexpr size_t WS_W     = 8 * MiB;
constexpr size_t W_IN0 = WS_W, W_GLU0 = W_IN0 + 4 * MiB, W_OUT0 = W_GLU0 + 2 * MiB;
constexpr size_t W_IN1 = W_OUT0 + 2 * MiB, W_OUT1 = W_IN1 + 5 * MiB;
constexpr size_t W_IN2 = W_OUT1 + 2 * MiB, W_GLU2 = W_IN2 + 4 * MiB, W_OUT2 = W_GLU2 + 2 * MiB;
constexpr size_t W_IN3 = W_OUT2 + 2 * MiB, W_OUT3 = W_IN3 + 5 * MiB;
constexpr size_t WS_BT1 = 40 * MiB;
constexpr size_t WS_BT3 = 56 * MiB;
constexpr size_t WS_XH  = 80 * MiB;
constexpr size_t WS_UH  = 208 * MiB;
constexpr size_t WS_GP  = 400 * MiB;
constexpr size_t WS_K   = WS_GP, WS_VT = WS_GP + 32 * MiB;
constexpr size_t WS_GATE = 528 * MiB;
constexpr size_t WS_ZG  = 656 * MiB;
constexpr size_t WS_OG  = 784 * MiB;
constexpr size_t WS_END = 912 * MiB;

struct Params { const float* in[36]; float* out; unsigned char* ws; };

constexpr int BM = 256, BK = 64, HALF = 128, HTB = HALF * BK * 2, STAGE_BYTES = 8 * HTB, NXCD = 8, WGM = 8;
__device__ __forceinline__ int lds_byte(int r, int c) { const int st = (r >> 4) * 2 + (c >> 5), rr = r & 15, cc = c & 31, ob = rr * 64 + cc * 2; return st * 1024 + (ob ^ (((ob >> 9) & 1) << 5)); }
__device__ __forceinline__ void stage_rc(int b, int& R, int& C) { const int st = b / 1024, sb = b % 1024, swz = sb ^ (((sb >> 9) & 1) << 5); R = (st >> 1) * 16 + swz / 64; C = (st & 1) * 32 + (swz % 64) / 2; }
__device__ __forceinline__ int perm32(int rho) { const int n = rho >> 4, i = rho & 15; return 8 * (i >> 2) + 4 * n + (i & 3); }

struct GUnit { const char* a; const char* b; int pm, pn, g; };
struct AGeo { unsigned lda, slab; size_t kstep; };

struct PlainOrder {
    int nM, nN, nwg, G, c; const char* A; const char* B; size_t ta, tb;
    __device__ __forceinline__ void init(int M, int N, int G_, int c_, const void* A_, size_t ta_, const void* B_, size_t tb_) { nM = M / BM; nN = N / BM; nwg = nM * nN; G = G_; c = c_; A = (const char*)A_; B = (const char*)B_; ta = ta_; tb = tb_; }
    __device__ __forceinline__ bool next(int i, GUnit& u) const {
        const long L = (long)i * G + c; if (L >= nwg) return false;
        int wgid = (int)L; { const int q = nwg / NXCD, r = nwg % NXCD, xcd = wgid % NXCD, off = wgid / NXCD; wgid = (xcd < r ? xcd * (q + 1) : r * (q + 1) + (xcd - r) * q) + off; }
        const int nig = WGM * nN, gid = wgid / nig, fm = gid * WGM, gsz = (nM - fm) < WGM ? (nM - fm) : WGM;
        u.pm = fm + ((wgid % nig) % gsz); u.pn = (wgid % nig) / gsz; u.g = 0;
        u.a = A + (size_t)u.pm * ta; u.b = B + (size_t)u.pn * tb; return true;
    }
};
struct GroupOrder {
    int G, c; const char* A; const char* B; size_t gsa, gsb, ta;
    __device__ __forceinline__ bool next(int i, GUnit& u) const {
        const long L = (long)i * G + c; if (L >= 1024) return false;
        int g, pm;
        if (G == 256) { const int xcd = c & 7, j = c >> 3; g = i * 16 + xcd * 2 + (j >> 4); pm = j & 15; }
        else { g = (int)(L >> 4); pm = (int)(L & 15); }
        u.g = g; u.pm = pm; u.pn = 0; u.a = A + (size_t)g * gsa + (size_t)pm * ta; u.b = B + (size_t)g * gsb; return true;
    }
};

template <class Epi, class Sched>
__device__ __forceinline__ void gemm_phase(LAS unsigned char* lds, const AGeo ga, const unsigned ldb, const int nt, const Sched& S, const Epi& E) {
    int tid = threadIdx.x; asm volatile("" : "+v"(tid));
    const int wid = __builtin_amdgcn_readfirstlane(tid >> 6), lane = tid & 63, wr = wid >> 2, wc = wid & 3, fr = lane & 15, fq = lane >> 4;
    unsigned voffA[2], voffB[2];
#pragma unroll
    for (int i = 0; i < 2; ++i) { int R, C; stage_rc(tid * 16 + i * 8192, R, C); const int Rb = (R & ~31) + perm32(R & 31);
        voffA[i] = (unsigned)R * ga.lda + (unsigned)(C >> 4) * ga.slab + (unsigned)(C & 15) * 2u; voffB[i] = (unsigned)Rb * ldb + (unsigned)C * 2u; }
    const size_t kA = ga.kstep, kB = 128;
    const size_t hA = (size_t)HALF * ga.lda, hB = (size_t)HALF * ldb;
    const unsigned ldsw = (unsigned)wid * 1024u;
    const int aoff = lds_byte(wr * 64 + fr, fq * 8), boff = lds_byte(wc * 32 + fr, fq * 8);
#define PG8_SA(b, h) (((b) * 2 + (h)) * HTB)
#define PG8_SB(b, h) ((4 + (b) * 2 + (h)) * HTB)
#define PG8_STAGE(bufoff, gbase, voff) do { _Pragma("unroll") for (int _i = 0; _i < 2; ++_i) \
        __builtin_amdgcn_global_load_lds((const unsigned*)((const char*)(gbase) + (voff)[_i]), (LAS unsigned*)(lds + (bufoff) + ldsw + _i * 8192), 16, 0, 0); } while (0)
#define PG8_LDA(dst, b, h) do { _Pragma("unroll") for (int m = 0; m < 4; ++m) _Pragma("unroll") for (int k = 0; k < 2; ++k) dst[m][k] = *(const LAS h8*)(lds + PG8_SA(b, h) + aoff + m * 2048 + k * 1024); } while (0)
#define PG8_LDB(dst, b, h) do { _Pragma("unroll") for (int n = 0; n < 2; ++n) _Pragma("unroll") for (int k = 0; k < 2; ++k) dst[n][k] = *(const LAS h8*)(lds + PG8_SB(b, h) + boff + n * 2048 + k * 1024); } while (0)
#define PG8_MMA(ai, bj, At, Bt) do { __builtin_amdgcn_s_setprio(1); _Pragma("unroll") for (int m = 0; m < 4; ++m) _Pragma("unroll") for (int n = 0; n < 2; ++n) _Pragma("unroll") for (int k = 0; k < 2; ++k) \
        acc[ai][bj][m][n] = __builtin_amdgcn_mfma_f32_16x16x32_f16(Bt[n][k], At[m][k], acc[ai][bj][m][n], 0, 0, 0); __builtin_amdgcn_s_setprio(0); } while (0)
#define PG8_WAIT_V(n) asm volatile("s_waitcnt vmcnt(" #n ")" ::: "memory")
#define PG8_WAIT_L(n) asm volatile("s_waitcnt lgkmcnt(" #n ")" ::: "memory")
#define PG8_BAR __builtin_amdgcn_s_barrier()
#define PG8_SCHED __builtin_amdgcn_sched_barrier(0)
    GUnit cur, nxt; int ui = 0;
    if (!S.next(0, cur)) return;
    f32x4 acc[2][2][4][2];
#pragma unroll
    for (int a = 0; a < 2; ++a)
#pragma unroll
        for (int b = 0; b < 2; ++b)
#pragma unroll
            for (int m = 0; m < 4; ++m)
#pragma unroll
                for (int n = 0; n < 2; ++n) acc[a][b][m][n] = (f32x4){0.f, 0.f, 0.f, 0.f};
    h8 At[4][2], B0[2][2], B1[2][2];
    const char* cA = cur.a; const char* cB = cur.b;
    PG8_STAGE(PG8_SB(0, 0), cB, voffB); PG8_STAGE(PG8_SB(0, 1), cB + hB, voffB); PG8_STAGE(PG8_SA(0, 0), cA, voffA); PG8_STAGE(PG8_SA(0, 1), cA + hA, voffA);
    if (wr == 1) PG8_BAR;
    PG8_WAIT_V(2); PG8_BAR;
    PG8_STAGE(PG8_SB(1, 0), cB + kB, voffB); PG8_STAGE(PG8_SA(1, 0), cA + kA, voffA); PG8_STAGE(PG8_SB(1, 1), cB + hB + kB, voffB);
    PG8_WAIT_V(6); PG8_BAR;
    for (;;) {
        const bool has_next = S.next(ui + 1, nxt);
        const char* nA = has_next ? nxt.a : cA; const char* nB = has_next ? nxt.b : cB;
#pragma unroll 1
        for (int t = 0; t < nt; t += 2) {
            const bool last = (t == nt - 2);
            const char* a1 = cA + (size_t)(t + 1) * kA;
            const char* a2 = last ? nA : cA + (size_t)(t + 2) * kA; const char* b2 = last ? nB : cB + (size_t)(t + 2) * kB;
            const char* a3 = a2 + kA; const char* b3 = b2 + kB;
            PG8_LDB(B0, 0, 0); PG8_LDB(B1, 0, 1); PG8_SCHED; PG8_LDA(At, 0, 0); PG8_STAGE(PG8_SA(1, 1), a1 + hA, voffA);
            PG8_WAIT_V(8); PG8_WAIT_L(0); PG8_BAR; PG8_MMA(0, 0, At, B0); PG8_MMA(0, 1, At, B1); PG8_BAR; PG8_SCHED;
            PG8_LDA(At, 0, 1); PG8_STAGE(PG8_SB(0, 0), b2, voffB); PG8_STAGE(PG8_SB(0, 1), b2 + hB, voffB); PG8_STAGE(PG8_SA(0, 0), a2, voffA);
            PG8_WAIT_V(8); PG8_WAIT_L(0); PG8_BAR; PG8_MMA(1, 0, At, B0); PG8_MMA(1, 1, At, B1); PG8_BAR; PG8_SCHED;
            PG8_LDB(B0, 1, 0); PG8_LDB(B1, 1, 1); PG8_SCHED; PG8_LDA(At, 1, 0); PG8_STAGE(PG8_SA(0, 1), a2 + hA, voffA);
            PG8_WAIT_V(8); PG8_WAIT_L(0); PG8_BAR; PG8_MMA(0, 0, At, B0); PG8_MMA(0, 1, At, B1); PG8_BAR; PG8_SCHED;
            PG8_LDA(At, 1, 1); PG8_STAGE(PG8_SB(1, 0), b3, voffB); PG8_STAGE(PG8_SB(1, 1), b3 + hB, voffB); PG8_STAGE(PG8_SA(1, 0), a3, voffA);
            PG8_WAIT_V(8); PG8_WAIT_L(0); PG8_BAR; PG8_MMA(1, 0, At, B0); PG8_MMA(1, 1, At, B1); PG8_BAR; PG8_SCHED;
        }
        if (wr == 0) PG8_BAR;
        E(acc, cur, wr, wc, fr, fq);
        if (!has_next) break;
#pragma unroll
        for (int a = 0; a < 2; ++a)
#pragma unroll
            for (int b = 0; b < 2; ++b)
#pragma unroll
                for (int m = 0; m < 4; ++m)
#pragma unroll
                    for (int n = 0; n < 2; ++n) acc[a][b][m][n] = (f32x4){0.f, 0.f, 0.f, 0.f};
        cur = nxt; cA = nA; cB = nB; ++ui;
        if (wr == 1) PG8_BAR;
    }
    PG8_WAIT_V(0);
    PG8_BAR;
#undef PG8_SA
#undef PG8_SB
#undef PG8_STAGE
#undef PG8_LDA
#undef PG8_LDB
#undef PG8_MMA
#undef PG8_WAIT_V
#undef PG8_WAIT_L
#undef PG8_BAR
#undef PG8_SCHED
}

__device__ __forceinline__ h8 pack8(f32x4 a, f32x4 b) { h8 r; r[0] = (h16)a[0]; r[1] = (h16)a[1]; r[2] = (h16)a[2]; r[3] = (h16)a[3]; r[4] = (h16)b[0]; r[5] = (h16)b[1]; r[6] = (h16)b[2]; r[7] = (h16)b[3]; return r; }
__device__ __forceinline__ float sigmoidf_(float x) { return __builtin_amdgcn_rcpf(1.0f + __expf(-x)); }

struct EpiG1Ssm {
    const float* sumsq; h16* UH; h16* gate;
    __device__ __forceinline__ void operator()(const f32x4 (&acc)[2][2][4][2], const GUnit& u, int wr, int wc, int fr, int fq) const {
#pragma unroll
        for (int ai = 0; ai < 2; ++ai)
#pragma unroll
            for (int m = 0; m < 4; ++m) {
                const int row = u.pm * BM + ai * HALF + wr * 64 + m * 16 + fr;
                const float rs = rsqrtf(sumsq[row] * (1.0f / DM) + NORM_EPS);
#pragma unroll
                for (int bj = 0; bj < 2; ++bj) {
                    const int ch0 = u.pn * BM + bj * HALF + wc * 32 + 8 * fq;
                    const h8 v = pack8(acc[ai][bj][m][0] * rs, acc[ai][bj][m][1] * rs);
                    if (ch0 < 1024) { const int g = ch0 >> 4, c0 = ch0 & 15;
                        *(h8*)(UH + ((size_t)g * ROWS_G + (row >> 4)) * UHK + (row & 15) * 16 + c0) = v; }
                    else *(h8*)(gate + (size_t)row * DM + (ch0 - 1024)) = v;
                }
            }
    }
};
struct EpiS1 {
    float* Gp;
    __device__ __forceinline__ void operator()(const f32x4 (&acc)[2][2][4][2], const GUnit& u, int wr, int wc, int fr, int fq) const {
#pragma unroll
        for (int ai = 0; ai < 2; ++ai)
#pragma unroll
            for (int m = 0; m < 4; ++m) {
                const int row = u.pm * BM + ai * HALF + wr * 64 + m * 16 + fr;
                float* p = Gp + ((size_t)u.g * ROWS_G + row) * 128 + wc * 32 + 8 * fq;
                *(f32x4*)p = acc[ai][0][m][0]; *(f32x4*)(p + 4) = acc[ai][0][m][1];
            }
    }
};
struct EpiS3 {
    const float* stepv; h16* Zg;
    static __device__ __forceinline__ float gelu1(float a) { return a * __builtin_amdgcn_rcpf(1.0f + __expf(-1.5957691216f * (a + 0.044715f * a * a * a))); }
    __device__ __forceinline__ void operator()(const f32x4 (&acc)[2][2][4][2], const GUnit& u, int wr, int wc, int fr, int fq) const {
        const float st = stepv[u.g];
        h16* base = Zg + (size_t)u.g * M_TOK * 16 + (size_t)(u.pm * BM + wr * 64 + fr) * 256 + wc * 32 + 8 * fq;
#pragma unroll
        for (int ai = 0; ai < 2; ++ai)
#pragma unroll
            for (int m = 0; m < 4; ++m) {
#pragma unroll
                for (int bj = 0; bj < 2; ++bj) {
                    const f32x4 y0 = acc[ai][bj][m][0] * st, y1 = acc[ai][bj][m][1] * st;
                    h8 o;
#pragma unroll
                    for (int j = 0; j < 4; ++j) { o[j] = (h16)gelu1(y0[j]); o[4 + j] = (h16)gelu1(y1[j]); }
                    *(h8*)(base + (size_t)(ai * HALF + m * 16) * 256 + bj * HALF) = o;
                    __builtin_amdgcn_sched_barrier(0);
                }
            }
    }
};
struct EpiGlu {
    const h16* Zg; const h16* gate; const float* bias; h16* og;
    __device__ __forceinline__ void operator()(const f32x4 (&acc)[2][2][4][2], const GUnit& u, int wr, int wc, int fr, int fq) const {
#pragma unroll
        for (int bj = 0; bj < 2; ++bj) {
            const int n0 = u.pn * BM + bj * HALF + wc * 32 + 8 * fq;
            const f32x4 b0 = *(const f32x4*)(bias + n0), b1 = *(const f32x4*)(bias + n0 + 4);
#pragma unroll
            for (int ai = 0; ai < 2; ++ai)
#pragma unroll
                for (int m = 0; m < 4; ++m) {
                    const int row = u.pm * BM + ai * HALF + wr * 64 + m * 16 + fr;
                    const h8 z = *(const h8*)(Zg + ((size_t)(n0 >> 4) * M_TOK + row) * 16 + (n0 & 15));
                    const h8 gt = *(const h8*)(gate + (size_t)row * DM + n0);
                    const f32x4 a0 = acc[ai][bj][m][0] + b0, a1 = acc[ai][bj][m][1] + b1;
                    h8 o;
#pragma unroll
                    for (int j = 0; j < 4; ++j) {
                        const float g0 = (float)gt[j], g1 = (float)gt[4 + j];
                        o[j] = (h16)((float)z[j] * sigmoidf_(a0[j]) * g0 * sigmoidf_(g0));
                        o[4 + j] = (h16)((float)z[4 + j] * sigmoidf_(a1[j]) * g1 * sigmoidf_(g1));
                    }
                    *(h8*)(og + (size_t)row * DM + n0) = o;
                }
        }
    }
};
struct EpiOut {
    const float* xin; float* xout; h16* xh; float* sumsq;
    __device__ __forceinline__ void operator()(const f32x4 (&acc)[2][2][4][2], const GUnit& u, int wr, int wc, int fr, int fq) const {
#pragma unroll
        for (int ai = 0; ai < 2; ++ai)
#pragma unroll
            for (int m = 0; m < 4; ++m) {
                const int row = u.pm * BM + ai * HALF + wr * 64 + m * 16 + fr;
                float ss = 0.f;
#pragma unroll
                for (int bj = 0; bj < 2; ++bj) {
                    const size_t off = (size_t)row * DM + u.pn * BM + bj * HALF + wc * 32 + 8 * fq;
                    const f32x4 v0 = *(const f32x4*)(xin + off) + acc[ai][bj][m][0], v1 = *(const f32x4*)(xin + off + 4) + acc[ai][bj][m][1];
                    *(f32x4*)(xout + off) = v0; *(f32x4*)(xout + off + 4) = v1;
                    *(h8*)(xh + off) = pack8(v0, v1);
                    ss += (v0[0] * v0[0] + v0[1] * v0[1]) + (v0[2] * v0[2] + v0[3] * v0[3]) + (v1[0] * v1[0] + v1[1] * v1[1]) + (v1[2] * v1[2] + v1[3] * v1[3]);
                }
                ss += __shfl_xor(ss, 16); ss += __shfl_xor(ss, 32);
                if (fq == 0) atomicAdd(sumsq + row, ss);
            }
    }
};
struct EpiG1Att {
    const float* sumsq; const f32x2* rope; h16* q; h16* k; h16* vt; h16* gate;
    __device__ __forceinline__ void operator()(const f32x4 (&acc)[2][2][4][2], const GUnit& u, int wr, int wc, int fr, int fq) const {
#pragma unroll
        for (int ai = 0; ai < 2; ++ai)
#pragma unroll
            for (int m = 0; m < 4; ++m) {
                const int row = u.pm * BM + ai * HALF + wr * 64 + m * 16 + fr;
                const int l = row & (SEQ - 1);
                const float rs = rsqrtf(sumsq[row] * (1.0f / DM) + NORM_EPS);
#pragma unroll
                for (int bj = 0; bj < 2; ++bj) {
                    const int ct = bj * HALF + wc * 32 + 8 * fq;
                    f32x4 v0 = acc[ai][bj][m][0] * rs, v1 = acc[ai][bj][m][1] * rs;
                    if (u.pn < 4 || (u.pn == 4 && bj == 0)) {
                        const int i0 = (ct & 63) >> 1;
                        const f32x2 cs0 = rope[l * 32 + i0], cs1 = rope[l * 32 + i0 + 1], cs2 = rope[l * 32 + i0 + 2], cs3 = rope[l * 32 + i0 + 3];
                        const float sc = (u.pn < 4) ? 0.125f * LOG2E : 1.0f;
                        f32x4 r0, r1;
                        r0[0] = (v0[0] * cs0.x - v0[1] * cs0.y) * sc; r0[1] = (v0[1] * cs0.x + v0[0] * cs0.y) * sc;
                        r0[2] = (v0[2] * cs1.x - v0[3] * cs1.y) * sc; r0[3] = (v0[3] * cs1.x + v0[2] * cs1.y) * sc;
                        r1[0] = (v1[0] * cs2.x - v1[1] * cs2.y) * sc; r1[1] = (v1[1] * cs2.x + v1[0] * cs2.y) * sc;
                        r1[2] = (v1[2] * cs3.x - v1[3] * cs3.y) * sc; r1[3] = (v1[3] * cs3.x + v1[2] * cs3.y) * sc;
                        const h8 o = pack8(r0, r1);
                        if (u.pn < 4) *(h8*)(q + (size_t)row * DM + u.pn * BM + ct) = o;
                        else *(h8*)(k + (size_t)row * 128 + ct) = o;
                    } else if (u.pn == 4) {
                        const int vc = ct - 128, kvh = vc >> 6, d0 = vc & 63, b = row >> 13;
                        h16* dst = vt + ((size_t)((b * 2 + kvh) * 64 + d0)) * SEQ + l;
#pragma unroll
                        for (int j = 0; j < 4; ++j) { dst[(size_t)j * SEQ] = (h16)v0[j]; dst[(size_t)(4 + j) * SEQ] = (h16)v1[j]; }
                    } else {
                        *(h8*)(gate + (size_t)row * DM + (u.pn - 5) * BM + ct) = pack8(v0, v1);
                    }
                }
            }
    }
};

__device__ __forceinline__ float wave_sum(float v) {
#pragma unroll
    for (int o = 1; o < 64; o <<= 1) v += __shfl_xor(v, o);
    return v;
}
template <int MODE>
__device__ __forceinline__ void transpose_item(const float* W, int K, int N, h16* WT, const float* gsc, LAS float* scr, int item, int lane) {
    const int nblk = N / 32, kb = item / nblk, nb = item % nblk, k0 = 64 * kb, n0 = 32 * nb;
    const int nd = n0 + (lane & 31); int src = nd;
    if (MODE == 1 && nd < 1152) { const int j = nd & 63; src = (nd & ~63) + (j >> 1) + 32 * (j & 1); }
#pragma unroll 8
    for (int i = 0; i < 32; ++i) { const int kk = 2 * i + (lane >> 5); float v = W[(size_t)(k0 + kk) * N + src]; if (gsc) v *= gsc[k0 + kk]; scr[kk * 33 + (lane & 31)] = v; }
    asm volatile("s_waitcnt lgkmcnt(0)" ::: "memory");
    const int c = lane & 7;
#pragma unroll
    for (int j = 0; j < 4; ++j) { const int n = (lane >> 3) + 8 * j; const LAS float* s = scr + (8 * c) * 33 + n;
        h8 o; o[0] = (h16)s[0 * 33]; o[1] = (h16)s[1 * 33]; o[2] = (h16)s[2 * 33]; o[3] = (h16)s[3 * 33]; o[4] = (h16)s[4 * 33]; o[5] = (h16)s[5 * 33]; o[6] = (h16)s[6 * 33]; o[7] = (h16)s[7 * 33];
        *(h8*)(WT + (size_t)(n0 + n) * K + k0 + 8 * c) = o; }
    asm volatile("s_waitcnt lgkmcnt(0)" ::: "memory");
}

__device__ __forceinline__ void ssm_prep_item(const Params& P, int L, int g, LAS unsigned char* lds) {
    const int base = (L == 0) ? 1 : 18;
    const float* a_re = P.in[base + 2] + g * 64; const float* a_im = P.in[base + 3] + g * 64; const float* log_step = P.in[base + 4];
    const float* b_re = P.in[base + 5] + g * 1024; const float* b_im = P.in[base + 6] + g * 1024;
    const float* c_re = P.in[base + 7] + g * 1024; const float* c_im = P.in[base + 8] + g * 1024;
    const float* dsk = P.in[base + 9] + g * 16;
    LAS float* apr = (LAS float*)lds;
    LAS float* api = apr + 64 * 17;
    LAS float* bbr = api + 64 * 17;
    LAS float* bbi = bbr + 1024;
    LAS float* km = bbi + 1024;
    const int tid = threadIdx.x;
    const double step = exp((double)log_step[g]);
    for (int e = tid; e < 64 * 17; e += 512) { const int p = e / 17, k = e % 17; const double mag = exp((double)k * step * (double)a_re[p]), ang = (double)k * step * (double)a_im[p];
        apr[e] = (float)(mag * cos(ang)); api[e] = (float)(mag * sin(ang)); }
    for (int e = tid; e < 1024; e += 512) { const int p = e >> 4; const double lr = a_re[p], li = a_im[p]; const double mag = exp(step * lr), ang = step * li;
        const double er = mag * cos(ang) - 1.0, ei = mag * sin(ang); const double den = (lr * lr + li * li) * step;
        const double cr = (er * lr + ei * li) / den, ci = (ei * lr - er * li) / den; const double br = b_re[e], bi = b_im[e];
        bbr[e] = (float)(cr * br - ci * bi); bbi[e] = (float)(cr * bi + ci * br); }
    __syncthreads();
    for (int e = tid; e < 4096; e += 512) { const int lag = e >> 8, c = (e >> 4) & 15, cp = e & 15; float s = 0.f;
        for (int p = 0; p < 64; ++p) { const float ar = apr[p * 17 + lag], ai = api[p * 17 + lag], br = bbr[p * 16 + cp], bi = bbi[p * 16 + cp];
            const float wr_ = ar * br - ai * bi, wi_ = ar * bi + ai * br; s += c_re[c * 64 + p] * wr_ - c_im[c * 64 + p] * wi_; }
        km[e] = s; }
    __syncthreads();
    h16* bt3 = (h16*)(P.ws + WS_BT3) + (size_t)(L * 64 + g) * 256 * 384;
    const float inv_step = (float)(1.0 / step);
    for (int e = tid; e < 256 * 384; e += 512) { const int n = e / 384, k = e % 384, t = n >> 4, c = n & 15; float v;
        if (k < 256) { const int s = k >> 4, cp = k & 15; v = (s <= t) ? km[((t - s) << 8) + (c << 4) + cp] : 0.f; if (s == t && c == cp) v += dsk[c] * inv_step; }
        else { const int kk = k - 256, p = kk & 63; const float ar = apr[p * 17 + t + 1], ai = api[p * 17 + t + 1], cr = c_re[c * 64 + p], ci = c_im[c * 64 + p];
            v = (kk < 64) ? (cr * ar - ci * ai) : -(cr * ai + ci * ar); }
        bt3[e] = (h16)v; }
    h16* bt1 = (h16*)(P.ws + WS_BT1) + (size_t)(L * 64 + g) * 256 * 256;
    for (int e = tid; e < 65536; e += 512) { const int n = e >> 8, k = e & 255, s = k >> 4, c = k & 15; float v = 0.f;
        if (n < 128) { const int p = n & 63; const float ar = apr[p * 17 + 15 - s], ai = api[p * 17 + 15 - s], br = bbr[p * 16 + c], bi = bbi[p * 16 + c];
            v = (n < 64) ? (ar * br - ai * bi) : (ar * bi + ai * br); }
        bt1[e] = (h16)v; }
    if (tid < 64) { const int p = tid; f32x2* a16 = (f32x2*)(P.ws + WS_A16) + (L * 64 + g) * 64; f32x2* asg = (f32x2*)(P.ws + WS_ASEG) + (L * 64 + g) * 64;
        a16[p] = (f32x2){apr[p * 17 + 16], api[p * 17 + 16]};
        const double mag = exp(2048.0 * step * (double)a_re[p]), ang = 2048.0 * step * (double)a_im[p]; asg[p] = (f32x2){(float)(mag * cos(ang)), (float)(mag * sin(ang))}; }
    if (tid == 0) ((float*)(P.ws + WS_STEP))[L * 64 + g] = (float)step;
    __syncthreads();
}

__device__ __forceinline__ void prep_phase(const Params& P, LAS unsigned char* lds) {
    const int tid = threadIdx.x, lane = tid & 63, wave = tid >> 6, G = gridDim.x;
    const int gw = blockIdx.x * 8 + wave, NGW = G * 8;
    for (int it = blockIdx.x; it < 128; it += G) ssm_prep_item(P, it >> 6, it & 63, lds);
    __syncthreads();
    { float* ss = (float*)(P.ws + WS_SUMSQ) + M_TOK; for (size_t i = (size_t)blockIdx.x * 512 + tid; i < (size_t)4 * M_TOK; i += (size_t)G * 512) ss[i] = 0.f; }
    { f32x2* rope = (f32x2*)(P.ws + WS_ROPE);
      for (int e = blockIdx.x * 512 + tid; e < SEQ * 32; e += G * 512) { const int l = e >> 5, i = e & 31; const float inv = (float)pow(10000.0, -(double)(2 * i) / 64.0); const float ang = (float)l * inv;
          rope[e] = (f32x2){(float)cos((double)ang), (float)sin((double)ang)}; } }
    LAS float* scr = (LAS float*)(lds + wave * 8704);
    constexpr int I_IN_S = 16 * 64, I_SQ = 16 * 32, I_IN_A = 16 * 72;
    constexpr int NITEMS = 2 * (I_IN_S + 2 * I_SQ) + 2 * (I_IN_A + I_SQ);
    unsigned char* ws = P.ws;
    for (int it = gw; it < NITEMS; it += NGW) {
        int r = it;
        if (r < I_IN_S) { transpose_item<0>(P.in[2], 1024, 2048, (h16*)(ws + W_IN0), P.in[1], scr, r, lane); continue; } r -= I_IN_S;
        if (r < I_SQ) { transpose_item<0>(P.in[11], 1024, 1024, (h16*)(ws + W_GLU0), nullptr, scr, r, lane); continue; } r -= I_SQ;
        if (r < I_SQ) { transpose_item<0>(P.in[13], 1024, 1024, (h16*)(ws + W_OUT0), nullptr, scr, r, lane); continue; } r -= I_SQ;
        if (r < I_IN_A) { transpose_item<1>(P.in[15], 1024, 2304, (h16*)(ws + W_IN1), P.in[14], scr, r, lane); continue; } r -= I_IN_A;
        if (r < I_SQ) { transpose_item<0>(P.in[17], 1024, 1024, (h16*)(ws + W_OUT1), nullptr, scr, r, lane); continue; } r -= I_SQ;
        if (r < I_IN_S) { transpose_item<0>(P.in[19], 1024, 2048, (h16*)(ws + W_IN2), P.in[18], scr, r, lane); continue; } r -= I_IN_S;
        if (r < I_SQ) { transpose_item<0>(P.in[28], 1024, 1024, (h16*)(ws + W_GLU2), nullptr, scr, r, lane); continue; } r -= I_SQ;
        if (r < I_SQ) { transpose_item<0>(P.in[30], 1024, 1024, (h16*)(ws + W_OUT2), nullptr, scr, r, lane); continue; } r -= I_SQ;
        if (r < I_IN_A) { transpose_item<1>(P.in[32], 1024, 2304, (h16*)(ws + W_IN3), P.in[31], scr, r, lane); continue; } r -= I_IN_A;
        transpose_item<0>(P.in[34], 1024, 1024, (h16*)(ws + W_OUT3), nullptr, scr, r, lane);
    }
    { const float* x = P.in[0]; h16* xh = (h16*)(ws + WS_XH); float* ss0 = (float*)(ws + WS_SUMSQ);
      for (int row = gw; row < M_TOK; row += NGW) { const f32x4* xr = (const f32x4*)(x + (size_t)row * DM) + lane; h4* o = (h4*)(xh + (size_t)row * DM) + lane; float s = 0.f;
#pragma unroll
          for (int j = 0; j < 4; ++j) { const f32x4 v = xr[64 * j]; s += (v[0] * v[0] + v[1] * v[1]) + (v[2] * v[2] + v[3] * v[3]); h4 hv; hv[0] = (h16)v[0]; hv[1] = (h16)v[1]; hv[2] = (h16)v[2]; hv[3] = (h16)v[3]; o[64 * j] = hv; }
          s = wave_sum(s); if (lane == 0) ss0[row] = s; } }
}

__device__ __forceinline__ void s2_phase(const Params& P, int L, LAS unsigned char* lds) {
    int tid = threadIdx.x; asm volatile("" : "+v"(tid));
    const int lane = tid & 63, wave = tid >> 6, seg = wave & 3;
    LAS f32x2* E = (LAS f32x2*)lds;
    for (int gb0 = blockIdx.x * 2; gb0 < 512; gb0 += gridDim.x * 2) {
        const int gb = gb0 + (wave >> 2), g = gb >> 3, b = gb & 7;
        const f32x2 a = ((const f32x2*)(P.ws + WS_A16))[(L * 64 + g) * 64 + lane];
        const f32x2 as = ((const f32x2*)(P.ws + WS_ASEG))[(L * 64 + g) * 64 + lane];
        const float* Gp = (const float*)(P.ws + WS_GP) + ((size_t)g * ROWS_G + b * 512 + seg * 128) * 128 + lane;
        float hr = 0.f, hi = 0.f;
        for (int n = 0; n < 128; n += 8) {
            float gr[8], gi[8];
#pragma unroll
            for (int j = 0; j < 8; ++j) { gr[j] = Gp[(size_t)(n + j) * 128]; gi[j] = Gp[(size_t)(n + j) * 128 + 64]; }
#pragma unroll
            for (int j = 0; j < 8; ++j) { const float t = a.x * hr - a.y * hi + gr[j]; hi = a.x * hi + a.y * hr + gi[j]; hr = t; }
        }
        E[wave * 64 + lane] = (f32x2){hr, hi};
        __syncthreads();
        float sr = 0.f, si = 0.f;
        for (int i = 0; i < seg; ++i) { const f32x2 e = E[((wave & ~3) + i) * 64 + lane]; const float t = as.x * sr - as.y * si + e.x; si = as.x * si + as.y * sr + e.y; sr = t; }
        h16* H = (h16*)(P.ws + WS_UH) + ((size_t)g * ROWS_G + b * 512 + seg * 128) * UHK + 256 + lane;
        hr = sr; hi = si;
        for (int n = 0; n < 128; n += 8) {
            float gr[8], gi[8];
#pragma unroll
            for (int j = 0; j < 8; ++j) { gr[j] = Gp[(size_t)(n + j) * 128]; gi[j] = Gp[(size_t)(n + j) * 128 + 64]; }
#pragma unroll
            for (int j = 0; j < 8; ++j) { H[(size_t)(n + j) * UHK] = (h16)hr; H[(size_t)(n + j) * UHK + 64] = (h16)hi;
                const float t = a.x * hr - a.y * hi + gr[j]; hi = a.x * hi + a.y * hr + gi[j]; hr = t; }
        }
        __syncthreads();
    }
}

__device__ __forceinline__ int crow(int r, int hi) { return (r & 3) + 8 * (r >> 2) + 4 * hi; }
__device__ __forceinline__ void attn_phase(const Params& P, int layer, LAS unsigned char* lds) {
    const h16* q = (const h16*)(P.ws + WS_UH); const h16* k = (const h16*)(P.ws + WS_K); const h16* vt = (const h16*)(P.ws + WS_VT);
    const h16* gate = (const h16*)(P.ws + WS_GATE); h16* og = (h16*)(P.ws + WS_OG);
    const float* sinks = P.in[layer == 1 ? 16 : 33];
    int tid = threadIdx.x; asm volatile("" : "+v"(tid));
    const int lane = tid & 63, wave = tid >> 6, l31 = lane & 31, hi = lane >> 5;
    LAS h16* Ks = (LAS h16*)lds;
    LAS h16* Vs = (LAS h16*)(lds + 256 * 144);
    for (int unit = blockIdx.x; unit < 1024; unit += gridDim.x) {
        const int kvh = unit & 1, blk = (unit >> 1) & 63, b = unit >> 7;
        __syncthreads();
#pragma unroll
        for (int i = 0; i < 4; ++i) { const int id = tid + 512 * i, key = id >> 3, part = id & 7; const int l = blk * 128 - 128 + key;
            h8 val = (h8)(h16)0.f; if (l >= 0) val = *(const h8*)(k + ((size_t)b * SEQ + l) * 128 + kvh * 64 + part * 8);
            *(LAS h8*)(Ks + key * 72 + part * 8) = val; }
#pragma unroll
        for (int i = 0; i < 4; ++i) { const int id = tid + 512 * i, d = id >> 5, part = id & 31; const int l0 = blk * 128 - 128 + part * 8;
            h8 val = (h8)(h16)0.f; if (l0 >= 0) val = *(const h8*)(vt + ((size_t)((b * 2 + kvh) * 64 + d)) * SEQ + l0);
            LAS h16* dst = Vs + d * 260 + part * 8; *(LAS h4*)dst = val.lo; *(LAS h4*)(dst + 4) = val.hi; }
        __syncthreads();
        const int hq = kvh * 8 + wave; const float sink2 = sinks[hq] * LOG2E;
        for (int i = 0; i < 4; ++i) {
            const size_t tok0 = (size_t)b * SEQ + blk * 128 + 32 * i;
            h8 qf[4];
#pragma unroll
            for (int ds = 0; ds < 4; ++ds) qf[ds] = *(const h8*)(q + (tok0 + l31) * DM + hq * 64 + 16 * ds + 8 * hi);
            f32x16 s[5];
#pragma unroll
            for (int t5 = 0; t5 < 5; ++t5) { f32x16 a16;
#pragma unroll
                for (int r = 0; r < 16; ++r) a16[r] = 0.f;
#pragma unroll
                for (int ds = 0; ds < 4; ++ds) { const h8 kf = *(const LAS h8*)(Ks + (32 * (i + t5) + l31) * 72 + 16 * ds + 8 * hi); a16 = __builtin_amdgcn_mfma_f32_32x32x16_f16(kf, qf[ds], a16, 0, 0, 0); }
                s[t5] = a16; }
            const int qi = 32 * i + l31;
            float mx = sink2;
#pragma unroll
            for (int t5 = 0; t5 < 5; ++t5)
#pragma unroll
                for (int r = 0; r < 16; ++r) { const int kj = 32 * (i + t5) + crow(r, hi); const bool valid = (kj > qi) && (kj <= qi + 128) && (blk > 0 || kj >= 128);
                    const float v = valid ? s[t5][r] : -1e30f; s[t5][r] = v; mx = fmaxf(mx, v); }
            mx = fmaxf(mx, __shfl_xor(mx, 32));
            float sum = 0.f;
#pragma unroll
            for (int t5 = 0; t5 < 5; ++t5)
#pragma unroll
                for (int r = 0; r < 16; ++r) { const float p = __builtin_amdgcn_exp2f(s[t5][r] - mx); s[t5][r] = p; sum += p; }
            sum += __shfl_xor(sum, 32);
            sum += __builtin_amdgcn_exp2f(sink2 - mx);
            const float inv = 1.0f / sum;
            f32x16 o0, o1;
#pragma unroll
            for (int r = 0; r < 16; ++r) { o0[r] = 0.f; o1[r] = 0.f; }
#pragma unroll
            for (int t5 = 0; t5 < 5; ++t5)
#pragma unroll
                for (int ss = 0; ss < 2; ++ss) { h8 pf;
#pragma unroll
                    for (int j = 0; j < 8; ++j) pf[j] = (h16)(s[t5][8 * ss + j] * inv);
                    const int kb = 32 * (i + t5) + 16 * ss + 4 * hi;
                    { const LAS h16* vp = Vs + l31 * 260 + kb; const h4 lo = *(const LAS h4*)vp, hi4 = *(const LAS h4*)(vp + 8);
                      const h8 vf = __builtin_shufflevector(lo, hi4, 0, 1, 2, 3, 4, 5, 6, 7); o0 = __builtin_amdgcn_mfma_f32_32x32x16_f16(pf, vf, o0, 0, 0, 0); }
                    { const LAS h16* vp = Vs + (32 + l31) * 260 + kb; const h4 lo = *(const LAS h4*)vp, hi4 = *(const LAS h4*)(vp + 8);
                      const h8 vf = __builtin_shufflevector(lo, hi4, 0, 1, 2, 3, 4, 5, 6, 7); o1 = __builtin_amdgcn_mfma_f32_32x32x16_f16(pf, vf, o1, 0, 0, 0); } }
#pragma unroll
            for (int r = 0; r < 16; ++r) { const size_t off = (tok0 + crow(r, hi)) * DM + hq * 64 + l31;
                const float g0 = (float)gate[off], g1 = (float)gate[off + 32];
                og[off] = (h16)(o0[r] * g0 * sigmoidf_(g0)); og[off + 32] = (h16)(o1[r] * g1 * sigmoidf_(g1)); }
        }
    }
}

__device__ __forceinline__ void final_norm_phase(const Params& P) {
    const int tid = threadIdx.x, lane = tid & 63, wave = tid >> 6; const int gw = blockIdx.x * 8 + wave, NGW = gridDim.x * 8;
    const float* ss = (const float*)(P.ws + WS_SUMSQ) + (size_t)4 * M_TOK; const f32x4* gn = (const f32x4*)P.in[35];
    f32x4 gv[4];
#pragma unroll
    for (int j = 0; j < 4; ++j) gv[j] = gn[64 * j + lane];
    for (int row = gw; row < M_TOK; row += NGW) { const float rs = rsqrtf(ss[row] * (1.0f / DM) + NORM_EPS); f32x4* xr = (f32x4*)(P.out + (size_t)row * DM) + lane;
#pragma unroll
        for (int j = 0; j < 4; ++j) { const f32x4 v = xr[64 * j]; xr[64 * j] = v * rs * gv[j]; } }
}

constexpr int LDS_BYTES = 135168;
__global__ void __launch_bounds__(512) fwd_megakernel(Params P) {
    extern __shared__ __attribute__((aligned(16))) unsigned char lds_raw[];
    LAS unsigned char* lds = (LAS unsigned char*)lds_raw;
    cg::grid_group grid = cg::this_grid();
    const int G = gridDim.x, c = blockIdx.x;
    unsigned char* ws = P.ws;
    float* sumsq = (float*)(ws + WS_SUMSQ);
    h16* xh = (h16*)(ws + WS_XH); h16* UH = (h16*)(ws + WS_UH); float* Gp = (float*)(ws + WS_GP); h16* gate = (h16*)(ws + WS_GATE);
    h16* Zg = (h16*)(ws + WS_ZG); h16* og = (h16*)(ws + WS_OG);
    const AGeo plainA{2048u, 32u, 128};

#ifndef PH_MASK
#define PH_MASK 0xFFFF
#endif
    if (PH_MASK & 1) prep_phase(P, lds);
    grid.sync();

#pragma unroll 1
    for (int layer = 0; layer < 4; ++layer) {
        const float* xin = (layer == 0) ? P.in[0] : P.out;
        if ((layer & 1) == 0) {
            const int L = layer >> 1;
            const unsigned char* win = ws + (L ? W_IN2 : W_IN0); const unsigned char* wglu = ws + (L ? W_GLU2 : W_GLU0); const unsigned char* wout = ws + (L ? W_OUT2 : W_OUT0);
            const float* bglu = P.in[L ? 29 : 12];
            { PlainOrder S; S.init(M_TOK, 2048, G, c, xh, (size_t)256 * 2048, win, (size_t)256 * 2048);
              EpiG1Ssm E{sumsq + (size_t)layer * M_TOK, UH, gate};
              if (PH_MASK & 2) gemm_phase(lds, plainA, 2048u, 16, S, E); }
            grid.sync();
            { GroupOrder S{G, c, (const char*)UH, (const char*)(ws + WS_BT1) + (size_t)L * 64 * 256 * 256 * 2, (size_t)ROWS_G * UHK * 2, (size_t)256 * 256 * 2, (size_t)256 * UHK * 2};
              EpiS1 E{Gp};
              if (PH_MASK & 4) gemm_phase(lds, AGeo{UHK * 2u, 32u, 128}, 512u, 4, S, E); }
            grid.sync();
            if (PH_MASK & 8) s2_phase(P, L, lds);
            grid.sync();
            { GroupOrder S{G, c, (const char*)UH, (const char*)(ws + WS_BT3) + (size_t)L * 64 * 256 * 384 * 2, (size_t)ROWS_G * UHK * 2, (size_t)256 * 384 * 2, (size_t)256 * UHK * 2};
              EpiS3 E{(const float*)(ws + WS_STEP) + L * 64, Zg};
              if (PH_MASK & 16) gemm_phase(lds, AGeo{UHK * 2u, 32u, 128}, 768u, 6, S, E); }
            grid.sync();
            { PlainOrder S; S.init(M_TOK, 1024, G, c, Zg, (size_t)256 * 32, wglu, (size_t)256 * 2048);
              EpiGlu E{Zg, gate, bglu, og};
              if (PH_MASK & 32) gemm_phase(lds, AGeo{32u, (unsigned)(M_TOK * 32), (size_t)4 * M_TOK * 32}, 2048u, 16, S, E); }
            grid.sync();
            { PlainOrder S; S.init(M_TOK, 1024, G, c, og, (size_t)256 * 2048, wout, (size_t)256 * 2048);
              EpiOut E{xin, P.out, xh, sumsq + (size_t)(layer + 1) * M_TOK};
              if (PH_MASK & 64) gemm_phase(lds, plainA, 2048u, 16, S, E); }
            grid.sync();
        } else {
            const unsigned char* win = ws + (layer == 1 ? W_IN1 : W_IN3); const unsigned char* wout = ws + (layer == 1 ? W_OUT1 : W_OUT3);
            { PlainOrder S; S.init(M_TOK, 2304, G, c, xh, (size_t)256 * 2048, win, (size_t)256 * 2048);
              EpiG1Att E{sumsq + (size_t)layer * M_TOK, (const f32x2*)(ws + WS_ROPE), (h16*)(ws + WS_UH), (h16*)(ws + WS_K), (h16*)(ws + WS_VT), gate};
              if (PH_MASK & 128) gemm_phase(lds, plainA, 2048u, 16, S, E); }
            grid.sync();
            if (PH_MASK & 256) attn_phase(P, layer, lds);
            grid.sync();
            { PlainOrder S; S.init(M_TOK, 1024, G, c, og, (size_t)256 * 2048, wout, (size_t)256 * 2048);
              EpiOut E{xin, P.out, xh, sumsq + (size_t)(layer + 1) * M_TOK};
              if (PH_MASK & 512) gemm_phase(lds, plainA, 2048u, 16, S, E); }
            grid.sync();
        }
    }
    if (PH_MASK & 1024) final_norm_phase(P);
}

extern "C" void kernel_launch(void* const* d_in, const int* in_sizes, int n_in, void* d_out, int out_size, void* d_ws, size_t ws_size, hipStream_t stream) {
    static int grid_blocks = 0;
    if (grid_blocks == 0) {
        if (n_in != 36 || ws_size < WS_END) { fprintf(stderr, "kernel_launch: unexpected n_in %d / ws %zu\n", n_in, ws_size); grid_blocks = -1; return; }
        int dev = 0, cus = 0, per_cu = 0;
        hipGetDevice(&dev);
        hipDeviceGetAttribute(&cus, hipDeviceAttributeMultiprocessorCount, dev);
        hipFuncSetAttribute((const void*)fwd_megakernel, hipFuncAttributeMaxDynamicSharedMemorySize, LDS_BYTES);
        hipOccupancyMaxActiveBlocksPerMultiprocessor(&per_cu, (const void*)fwd_megakernel, 512, LDS_BYTES);
        if (per_cu < 1) per_cu = 1;
        grid_blocks = cus * per_cu;
        (void)hipGetLastError();
    }
    if (grid_blocks < 0) return;
    Params p{};
    for (int i = 0; i < 36; ++i) p.in[i] = (const float*)d_in[i];
    p.out = (float*)d_out; p.ws = (unsigned char*)d_ws;
    void* args[] = {&p};
    hipError_t e = hipLaunchCooperativeKernel((const void*)fwd_megakernel, dim3(grid_blocks), dim3(512), args, LDS_BYTES, stream);
    if (e != hipSuccess) fprintf(stderr, "cooperative launch failed: %s (grid %d)\n", hipGetErrorString(e), grid_blocks);
}
```

```cpp
#include <hip/hip_runtime.h>
#include <hip/hip_cooperative_groups.h>
#include <cstdint>
#include <cstdio>
namespace cg = cooperative_groups;

#define LAS __attribute__((address_space(3)))
typedef _Float16 h16;
typedef _Float16 h8 __attribute__((ext_vector_type(8)));
typedef _Float16 h4 __attribute__((ext_vector_type(4)));
typedef float f32x4 __attribute__((ext_vector_type(4)));
typedef float f32x2 __attribute__((ext_vector_type(2)));
typedef float f32x16 __attribute__((ext_vector_type(16)));

constexpr int M_TOK = 65536, DM = 1024, SEQ = 8192;
constexpr int ROWS_G = 4096;
constexpr int UHK = 384;
constexpr float NORM_EPS = 1e-5f;
constexpr float LOG2E = 1.4426950408889634f;

constexpr size_t MiB = 1u << 20;
constexpr size_t WS_SUMSQ = 0;
constexpr size_t WS_ROPE  = 2 * MiB;
constexpr size_t WS_A16   = 4 * MiB;
constexpr size_t WS_ASEG  = 4 * MiB + 65536;
constexpr size_t WS_STEP  = 4 * MiB + 131072;
constexpr size_t WS_W     = 8 * MiB;
constexpr size_t W_IN0 = WS_W, W_GLU0 = W_IN0 + 4 * MiB, W_OUT0 = W_GLU0 + 2 * MiB;
constexpr size_t W_IN1 = W_OUT0 + 2 * MiB, W_OUT1 = W_IN1 + 5 * MiB;
constexpr size_t W_IN2 = W_OUT1 + 2 * MiB, W_GLU2 = W_IN2 + 4 * MiB, W_OUT2 = W_GLU2 + 2 * MiB;
constexpr size_t W_IN3 = W_OUT2 + 2 * MiB, W_OUT3 = W_IN3 + 5 * MiB;
constexpr size_t WS_BT1 = 40 * MiB;
constexpr size_t WS_BT3 = 56 * MiB;
constexpr size_t WS_XH  = 80 * MiB;
constexpr size_t WS_UH  = 208 * MiB;
constexpr size_t WS_GP  = 400 * MiB;
constexpr size_t WS_K   = WS_GP, WS_VT = WS_GP + 32 * MiB;
constexpr size_t WS_GATE = 528 * MiB;
constexpr size_t WS_ZG  = 656 * MiB;
constexpr size_t WS_OG  = 784 * MiB;
constexpr size_t WS_END = 912 * MiB;

struct Params { const float* in[36]; float* out; unsigned char* ws; };

constexpr int BM = 256, BK = 64, HALF = 128, HTB = HALF * BK * 2, STAGE_BYTES = 8 * HTB, NXCD = 8, WGM = 8;
__device__ __forceinline__ int lds_byte(int r, int c) { const int st = (r >> 4) * 2 + (c >> 5), rr = r & 15, cc = c & 31, ob = rr * 64 + cc * 2; return st * 1024 + (ob ^ (((ob >> 9) & 1) << 5)); }
__device__ __forceinline__ void stage_rc(int b, int& R, int& C) { const int st = b / 1024, sb = b % 1024, swz = sb ^ (((sb >> 9) & 1) << 5); R = (st >> 1) * 16 + swz / 64; C = (st & 1) * 32 + (swz % 64) / 2; }
__device__ __forceinline__ int perm32(int rho) { const int n = rho >> 4, i = rho & 15; return 8 * (i >> 2) + 4 * n + (i & 3); }

struct GUnit { const char* a; const char* b; int pm, pn, g; };
struct AGeo { unsigned lda, slab; size_t kstep; };

struct PlainOrder {
    int nM, nN, nwg, G, c; const char* A; const char* B; size_t ta, tb;
    __device__ __forceinline__ void init(int M, int N, int G_, int c_, const void* A_, size_t ta_, const void* B_, size_t tb_) { nM = M / BM; nN = N / BM; nwg = nM * nN; G = G_; c = c_; A = (const char*)A_; B = (const char*)B_; ta = ta_; tb = tb_; }
    __device__ __forceinline__ bool next(int i, GUnit& u) const {
        const long L = (long)i * G + c; if (L >= nwg) return false;
        int wgid = (int)L; { const int q = nwg / NXCD, r = nwg % NXCD, xcd = wgid % NXCD, off = wgid / NXCD; wgid = (xcd < r ? xcd * (q + 1) : r * (q + 1) + (xcd - r) * q) + off; }
        const int nig = WGM * nN, gid = wgid / nig, fm = gid * WGM, gsz = (nM - fm) < WGM ? (nM - fm) : WGM;
        u.pm = fm + ((wgid % nig) % gsz); u.pn = (wgid % nig) / gsz; u.g = 0;
        u.a = A + (size_t)u.pm * ta; u.b = B + (size_t)u.pn * tb; return true;
    }
};
struct GroupOrder {
    int G, c; const char* A; const char* B; size_t gsa, gsb, ta;
    __device__ __forceinline__ bool next(int i, GUnit& u) const {
        const long L = (long)i * G + c; if (L >= 1024) return false;
        int g, pm;
        if (G == 256) { const int xcd = c & 7, j = c >> 3; g = i * 16 + xcd * 2 + (j >> 4); pm = j & 15; }
        else { g = (int)(L >> 4); pm = (int)(L & 15); }
        u.g = g; u.pm = pm; u.pn = 0; u.a = A + (size_t)g * gsa + (size_t)pm * ta; u.b = B + (size_t)g * gsb; return true;
    }
};

template <class Epi, class Sched>
__device__ __forceinline__ void gemm_phase(LAS unsigned char* lds, const AGeo ga, const unsigned ldb, const int nt, const Sched& S, const Epi& E) {
    int tid = threadIdx.x; asm volatile("" : "+v"(tid));
    const int wid = __builtin_amdgcn_readfirstlane(tid >> 6), lane = tid & 63, wr = wid >> 2, wc = wid & 3, fr = lane & 15, fq = lane >> 4;
    unsigned voffA[2], voffB[2];
#pragma unroll
    for (int i = 0; i < 2; ++i) { int R, C; stage_rc(tid * 16 + i * 8192, R, C); const int Rb = (R & ~31) + perm32(R & 31);
        voffA[i] = (unsigned)R * ga.lda + (unsigned)(C >> 4) * ga.slab + (unsigned)(C & 15) * 2u; voffB[i] = (unsigned)Rb * ldb + (unsigned)C * 2u; }
    const size_t kA = ga.kstep, kB = 128;
    const size_t hA = (size_t)HALF * ga.lda, hB = (size_t)HALF * ldb;
    const unsigned ldsw = (unsigned)wid * 1024u;
    const int aoff = lds_byte(wr * 64 + fr, fq * 8), boff = lds_byte(wc * 32 + fr, fq * 8);
#define PG8_SA(b, h) (((b) * 2 + (h)) * HTB)
#define PG8_SB(b, h) ((4 + (b) * 2 + (h)) * HTB)
#define PG8_STAGE(bufoff, gbase, voff) do { _Pragma("unroll") for (int _i = 0; _i < 2; ++_i) \
        __builtin_amdgcn_global_load_lds((const unsigned*)((const char*)(gbase) + (voff)[_i]), (LAS unsigned*)(lds + (bufoff) + ldsw + _i * 8192), 16, 0, 0); } while (0)
#define PG8_LDA(dst, b, h) do { _Pragma("unroll") for (int m = 0; m < 4; ++m) _Pragma("unroll") for (int k = 0; k < 2; ++k) dst[m][k] = *(const LAS h8*)(lds + PG8_SA(b, h) + aoff + m * 2048 + k * 1024); } while (0)
#define PG8_LDB(dst, b, h) do { _Pragma("unroll") for (int n = 0; n < 2; ++n) _Pragma("unroll") for (int k = 0; k < 2; ++k) dst[n][k] = *(const LAS h8*)(lds + PG8_SB(b, h) + boff + n * 2048 + k * 1024); } while (0)
#define PG8_MMA(ai, bj, At, Bt) do { __builtin_amdgcn_s_setprio(1); _Pragma("unroll") for (int m = 0; m < 4; ++m) _Pragma("unroll") for (int n = 0; n < 2; ++n) _Pragma("unroll") for (int k = 0; k < 2; ++k) \
        acc[ai][bj][m][n] = __builtin_amdgcn_mfma_f32_16x16x32_f16(Bt[n][k], At[m][k], acc[ai][bj][m][n], 0, 0, 0); __builtin_amdgcn_s_setprio(0); } while (0)
#define PG8_WAIT_V(n) asm volatile("s_waitcnt vmcnt(" #n ")" ::: "memory")
#define PG8_WAIT_L(n) asm volatile("s_waitcnt lgkmcnt(" #n ")" ::: "memory")
#define PG8_BAR __builtin_amdgcn_s_barrier()
#define PG8_SCHED __builtin_amdgcn_sched_barrier(0)
    GUnit cur, nxt; int ui = 0;
    if (!S.next(0, cur)) return;
    f32x4 acc[2][2][4][2];
#pragma unroll
    for (int a = 0; a < 2; ++a)
#pragma unroll
        for (int b = 0; b < 2; ++b)
#pragma unroll
            for (int m = 0; m < 4; ++m)
#pragma unroll
                for (int n = 0; n < 2; ++n) acc[a][b][m][n] = (f32x4){0.f, 0.f, 0.f, 0.f};
    h8 At[4][2], B0[2][2], B1[2][2];
    const char* cA = cur.a; const char* cB = cur.b;
    PG8_STAGE(PG8_SB(0, 0), cB, voffB); PG8_STAGE(PG8_SB(0, 1), cB + hB, voffB); PG8_STAGE(PG8_SA(0, 0), cA, voffA); PG8_STAGE(PG8_SA(0, 1), cA + hA, voffA);
    if (wr == 1) PG8_BAR;
    PG8_WAIT_V(2); PG8_BAR;
    PG8_STAGE(PG8_SB(1, 0), cB + kB, voffB); PG8_STAGE(PG8_SA(1, 0), cA + kA, voffA); PG8_STAGE(PG8_SB(1, 1), cB + hB + kB, voffB);
    PG8_WAIT_V(6); PG8_BAR;
    for (;;) {
        const bool has_next = S.next(ui + 1, nxt);
        const char* nA = has_next ? nxt.a : cA; const char* nB = has_next ? nxt.b : cB;
#pragma unroll 1
        for (int t = 0; t < nt; t += 2) {
            const bool last = (t == nt - 2);
            const char* a1 = cA + (size_t)(t + 1) * kA;
            const char* a2 = last ? nA : cA + (size_t)(t + 2) * kA; const char* b2 = last ? nB : cB + (size_t)(t + 2) * kB;
            const char* a3 = a2 + kA; const char* b3 = b2 + kB;
            PG8_LDB(B0, 0, 0); PG8_LDB(B1, 0, 1); PG8_SCHED; PG8_LDA(At, 0, 0); PG8_STAGE(PG8_SA(1, 1), a1 + hA, voffA);
            PG8_WAIT_V(8); PG8_WAIT_L(0); PG8_BAR; PG8_MMA(0, 0, At, B0); PG8_MMA(0, 1, At, B1); PG8_BAR; PG8_SCHED;
            PG8_LDA(At, 0, 1); PG8_STAGE(PG8_SB(0, 0), b2, voffB); PG8_STAGE(PG8_SB(0, 1), b2 + hB, voffB); PG8_STAGE(PG8_SA(0, 0), a2, voffA);
            PG8_WAIT_V(8); PG8_WAIT_L(0); PG8_BAR; PG8_MMA(1, 0, At, B0); PG8_MMA(1, 1, At, B1); PG8_BAR; PG8_SCHED;
            PG8_LDB(B0, 1, 0); PG8_LDB(B1, 1, 1); PG8_SCHED; PG8_LDA(At, 1, 0); PG8_STAGE(PG8_SA(0, 1), a2 + hA, voffA);
            PG8_WAIT_V(8); PG8_WAIT_L(0); PG8_BAR; PG8_MMA(0, 0, At, B0); PG8_MMA(0, 1, At, B1); PG8_BAR; PG8_SCHED;
            PG8_LDA(At, 1, 1); PG8_STAGE(PG8_SB(1, 0), b3, voffB); PG8_STAGE(PG8_SB(1, 1), b3 + hB, voffB); PG8_STAGE(PG8_SA(1, 0), a3, voffA);
            PG8_WAIT_V(8); PG8_WAIT_L(0); PG8_BAR; PG8_MMA(1, 0, At, B0); PG8_MMA(1, 1, At, B1); PG8_BAR; PG8_SCHED;
        }
        if (wr == 0) PG8_BAR;
        E(acc, cur, wr, wc, fr, fq);
        if (!has_next) break;
#pragma unroll
        for (int a = 0; a < 2; ++a)
#pragma unroll
            for (int b = 0; b < 2; ++b)
#pragma unroll
                for (int m = 0; m < 4; ++m)
#pragma unroll
                    for (int n = 0; n < 2; ++n) acc[a][b][m][n] = (f32x4){0.f, 0.f, 0.f, 0.f};
        cur = nxt; cA = nA; cB = nB; ++ui;
        if (wr == 1) PG8_BAR;
    }
    PG8_WAIT_V(0);
    PG8_BAR;
#undef PG8_SA
#undef PG8_SB
#undef PG8_STAGE
#undef PG8_LDA
#undef PG8_LDB
#undef PG8_MMA
#undef PG8_WAIT_V
#undef PG8_WAIT_L
#undef PG8_BAR
#undef PG8_SCHED
}

__device__ __forceinline__ h8 pack8(f32x4 a, f32x4 b) { h8 r; r[0] = (h16)a[0]; r[1] = (h16)a[1]; r[2] = (h16)a[2]; r[3] = (h16)a[3]; r[4] = (h16)b[0]; r[5] = (h16)b[1]; r[6] = (h16)b[2]; r[7] = (h16)b[3]; return r; }
__device__ __forceinline__ float sigmoidf_(float x) { return __builtin_amdgcn_rcpf(1.0f + __expf(-x)); }

struct EpiG1Ssm {
    const float* sumsq; h16* UH; h16* gate;
    __device__ __forceinline__ void operator()(const f32x4 (&acc)[2][2][4][2], const GUnit& u, int wr, int wc, int fr, int fq) const {
#pragma unroll
        for (int ai = 0; ai < 2; ++ai)
#pragma unroll
            for (int m = 0; m < 4; ++m) {
                const int row = u.pm * BM + ai * HALF + wr * 64 + m * 16 + fr;
                const float rs = rsqrtf(sumsq[row] * (1.0f / DM) + NORM_EPS);
#pragma unroll
                for (int bj = 0; bj < 2; ++bj) {
                    const int ch0 = u.pn * BM + bj * HALF + wc * 32 + 8 * fq;
                    const h8 v = pack8(acc[ai][bj][m][0] * rs, acc[ai][bj][m][1] * rs);
                    if (ch0 < 1024) { const int g = ch0 >> 4, c0 = ch0 & 15;
                        *(h8*)(UH + ((size_t)g * ROWS_G + (row >> 4)) * UHK + (row & 15) * 16 + c0) = v; }
                    else *(h8*)(gate + (size_t)row * DM + (ch0 - 1024)) = v;
                }
            }
    }
};
struct EpiS1 {
    float* Gp;
    __device__ __forceinline__ void operator()(const f32x4 (&acc)[2][2][4][2], const GUnit& u, int wr, int wc, int fr, int fq) const {
#pragma unroll
        for (int ai = 0; ai < 2; ++ai)
#pragma unroll
            for (int m = 0; m < 4; ++m) {
                const int row = u.pm * BM + ai * HALF + wr * 64 + m * 16 + fr;
                float* p = Gp + ((size_t)u.g * ROWS_G + row) * 128 + wc * 32 + 8 * fq;
                *(f32x4*)p = acc[ai][0][m][0]; *(f32x4*)(p + 4) = acc[ai][0][m][1];
            }
    }
};
struct EpiS3 {
    const float* stepv; h16* Zg;
    static __device__ __forceinline__ float gelu1(float a) { return a * __builtin_amdgcn_rcpf(1.0f + __expf(-1.5957691216f * (a + 0.044715f * a * a * a))); }
    __device__ __forceinline__ void operator()(const f32x4 (&acc)[2][2][4][2], const GUnit& u, int wr, int wc, int fr, int fq) const {
        const float st = stepv[u.g];
        h16* base = Zg + (size_t)u.g * M_TOK * 16 + (size_t)(u.pm * BM + wr * 64 + fr) * 256 + wc * 32 + 8 * fq;
#pragma unroll
        for (int ai = 0; ai < 2; ++ai)
#pragma unroll
            for (int m = 0; m < 4; ++m) {
#pragma unroll
                for (int bj = 0; bj < 2; ++bj) {
                    const f32x4 y0 = acc[ai][bj][m][0] * st, y1 = acc[ai][bj][m][1] * st;
                    h8 o;
#pragma unroll
                    for (int j = 0; j < 4; ++j) { o[j] = (h16)gelu1(y0[j]); o[4 + j] = (h16)gelu1(y1[j]); }
                    *(h8*)(base + (size_t)(ai * HALF + m * 16) * 256 + bj * HALF) = o;
                    __builtin_amdgcn_sched_barrier(0);
                }
            }
    }
};
struct EpiGlu {
    const h16* Zg; const h16* gate; const float* bias; h16* og;
    __device__ __forceinline__ void operator()(const f32x4 (&acc)[2][2][4][2], const GUnit& u, int wr, int wc, int fr, int fq) const {
#pragma unroll
        for (int bj = 0; bj < 2; ++bj) {
            const int n0 = u.pn * BM + bj * HALF + wc * 32 + 8 * fq;
            const f32x4 b0 = *(const f32x4*)(bias + n0), b1 = *(const f32x4*)(bias + n0 + 4);
#pragma unroll
            for (int ai = 0; ai < 2; ++ai)
#pragma unroll
                for (int m = 0; m < 4; ++m) {
                    const int row = u.pm * BM + ai * HALF + wr * 64 + m * 16 + fr;
                    const h8 z = *(const h8*)(Zg + ((size_t)(n0 >> 4) * M_TOK + row) * 16 + (n0 & 15));
                    const h8 gt = *(const h8*)(gate + (size_t)row * DM + n0);
                    const f32x4 a0 = acc[ai][bj][m][0] + b0, a1 = acc[ai][bj][m][1] + b1;
                    h8 o;
#pragma unroll
                    for (int j = 0; j < 4; ++j) {
                        const float g0 = (float)gt[j], g1 = (float)gt[4 + j];
                        o[j] = (h16)((float)z[j] * sigmoidf_(a0[j]) * g0 * sigmoidf_(g0));
                        o[4 + j] = (h16)((float)z[4 + j] * sigmoidf_(a1[j]) * g1 * sigmoidf_(g1));
                    }
                    *(h8*)(og + (size_t)row * DM + n0) = o;
                }
        }
    }
};
template <bool LAST>
struct EpiOut {
    h16* xh; float* xout; float* sumsq;
    __device__ __forceinline__ void operator()(const f32x4 (&acc)[2][2][4][2], const GUnit& u, int wr, int wc, int fr, int fq) const {
#pragma unroll
        for (int ai = 0; ai < 2; ++ai)
#pragma unroll
            for (int m = 0; m < 4; ++m) {
                const int row = u.pm * BM + ai * HALF + wr * 64 + m * 16 + fr;
                float ss = 0.f;
#pragma unroll
                for (int bj = 0; bj < 2; ++bj) {
                    const size_t off = (size_t)row * DM + u.pn * BM + bj * HALF + wc * 32 + 8 * fq;
                    const h8 xo = *(const h8*)(xh + off);
                    f32x4 v0, v1;
#pragma unroll
                    for (int j = 0; j < 4; ++j) { v0[j] = (float)xo[j] + acc[ai][bj][m][0][j]; v1[j] = (float)xo[4 + j] + acc[ai][bj][m][1][j]; }
                    if (LAST) { *(f32x4*)(xout + off) = v0; *(f32x4*)(xout + off + 4) = v1; }
                    else { const h8 xn = pack8(v0, v1); *(h8*)(xh + off) = xn;
#pragma unroll
                        for (int j = 0; j < 4; ++j) { v0[j] = (float)xn[j]; v1[j] = (float)xn[4 + j]; } }
                    ss += (v0[0] * v0[0] + v0[1] * v0[1]) + (v0[2] * v0[2] + v0[3] * v0[3]) + (v1[0] * v1[0] + v1[1] * v1[1]) + (v1[2] * v1[2] + v1[3] * v1[3]);
                }
                ss += __shfl_xor(ss, 16); ss += __shfl_xor(ss, 32);
                if (fq == 0) atomicAdd(sumsq + row, ss);
            }
    }
};
struct EpiG1Att {
    const float* sumsq; const f32x2* rope; h16* q; h16* k; h16* vt; h16* gate;
    __device__ __forceinline__ void operator()(const f32x4 (&acc)[2][2][4][2], const GUnit& u, int wr, int wc, int fr, int fq) const {
#pragma unroll
        for (int ai = 0; ai < 2; ++ai)
#pragma unroll
            for (int m = 0; m < 4; ++m) {
                const int row = u.pm * BM + ai * HALF + wr * 64 + m * 16 + fr;
                const int l = row & (SEQ - 1);
                const float rs = rsqrtf(sumsq[row] * (1.0f / DM) + NORM_EPS);
#pragma unroll
                for (int bj = 0; bj < 2; ++bj) {
                    const int ct = bj * HALF + wc * 32 + 8 * fq;
                    f32x4 v0 = acc[ai][bj][m][0] * rs, v1 = acc[ai][bj][m][1] * rs;
                    if (u.pn < 4 || (u.pn == 4 && bj == 0)) {
                        const int i0 = (ct & 63) >> 1;
                        const f32x2 cs0 = rope[l * 32 + i0], cs1 = rope[l * 32 + i0 + 1], cs2 = rope[l * 32 + i0 + 2], cs3 = rope[l * 32 + i0 + 3];
                        const float sc = (u.pn < 4) ? 0.125f * LOG2E : 1.0f;
                        f32x4 r0, r1;
                        r0[0] = (v0[0] * cs0.x - v0[1] * cs0.y) * sc; r0[1] = (v0[1] * cs0.x + v0[0] * cs0.y) * sc;
                        r0[2] = (v0[2] * cs1.x - v0[3] * cs1.y) * sc; r0[3] = (v0[3] * cs1.x + v0[2] * cs1.y) * sc;
                        r1[0] = (v1[0] * cs2.x - v1[1] * cs2.y) * sc; r1[1] = (v1[1] * cs2.x + v1[0] * cs2.y) * sc;
                        r1[2] = (v1[2] * cs3.x - v1[3] * cs3.y) * sc; r1[3] = (v1[3] * cs3.x + v1[2] * cs3.y) * sc;
                        const h8 o = pack8(r0, r1);
                        if (u.pn < 4) *(h8*)(q + (size_t)row * DM + u.pn * BM + ct) = o;
                        else *(h8*)(k + (size_t)row * 128 + ct) = o;
                    } else if (u.pn == 4) {
                        const int vc = ct - 128, kvh = vc >> 6, d0 = vc & 63, b = row >> 13;
                        h16* dst = vt + ((size_t)((b * 2 + kvh) * 64 + d0)) * SEQ + l;
#pragma unroll
                        for (int j = 0; j < 4; ++j) { dst[(size_t)j * SEQ] = (h16)v0[j]; dst[(size_t)(4 + j) * SEQ] = (h16)v1[j]; }
                    } else {
                        *(h8*)(gate + (size_t)row * DM + (u.pn - 5) * BM + ct) = pack8(v0, v1);
                    }
                }
            }
    }
};

__device__ __forceinline__ float wave_sum(float v) {
#pragma unroll
    for (int o = 1; o < 64; o <<= 1) v += __shfl_xor(v, o);
    return v;
}
template <int MODE>
__device__ __forceinline__ void transpose_item(const float* W, int K, int N, h16* WT, const float* gsc, LAS float* scr, int item, int lane) {
    const int nblk = N / 32, kb = item / nblk, nb = item % nblk, k0 = 64 * kb, n0 = 32 * nb;
    const int nd = n0 + (lane & 31); int src = nd;
    if (MODE == 1 && nd < 1152) { const int j = nd & 63; src = (nd & ~63) + (j >> 1) + 32 * (j & 1); }
#pragma unroll 8
    for (int i = 0; i < 32; ++i) { const int kk = 2 * i + (lane >> 5); float v = W[(size_t)(k0 + kk) * N + src]; if (gsc) v *= gsc[k0 + kk]; scr[kk * 33 + (lane & 31)] = v; }
    asm volatile("s_waitcnt lgkmcnt(0)" ::: "memory");
    const int c = lane & 7;
#pragma unroll
    for (int j = 0; j < 4; ++j) { const int n = (lane >> 3) + 8 * j; const LAS float* s = scr + (8 * c) * 33 + n;
        h8 o; o[0] = (h16)s[0 * 33]; o[1] = (h16)s[1 * 33]; o[2] = (h16)s[2 * 33]; o[3] = (h16)s[3 * 33]; o[4] = (h16)s[4 * 33]; o[5] = (h16)s[5 * 33]; o[6] = (h16)s[6 * 33]; o[7] = (h16)s[7 * 33];
        *(h8*)(WT + (size_t)(n0 + n) * K + k0 + 8 * c) = o; }
    asm volatile("s_waitcnt lgkmcnt(0)" ::: "memory");
}

__device__ __forceinline__ void ssm_prep_item(const Params& P, int L, int g, LAS unsigned char* lds) {
    const int base = (L == 0) ? 1 : 18;
    const float* a_re = P.in[base + 2] + g * 64; const float* a_im = P.in[base + 3] + g * 64; const float* log_step = P.in[base + 4];
    const float* b_re = P.in[base + 5] + g * 1024; const float* b_im = P.in[base + 6] + g * 1024;
    const float* c_re = P.in[base + 7] + g * 1024; const float* c_im = P.in[base + 8] + g * 1024;
    const float* dsk = P.in[base + 9] + g * 16;
    LAS float* apr = (LAS float*)lds;
    LAS float* api = apr + 64 * 17;
    LAS float* bbr = api + 64 * 17;
    LAS float* bbi = bbr + 1024;
    LAS float* km = bbi + 1024;
    LAS float* crs = km + 4096;
    LAS float* cis = crs + 1024;
    LAS float* cof = cis + 1024;
    const int tid = threadIdx.x;
    const double step = exp((double)log_step[g]);
    for (int e = tid; e < 1024; e += 512) { crs[e] = c_re[e]; cis[e] = c_im[e]; }
    for (int e = tid; e < 64 * 17; e += 512) { const int p = e / 17, k = e % 17; const double mag = exp((double)k * step * (double)a_re[p]), ang = (double)k * step * (double)a_im[p];
        apr[e] = (float)(mag * cos(ang)); api[e] = (float)(mag * sin(ang)); }
    if (tid < 64) { const int p = tid; const double lr = a_re[p], li = a_im[p]; const double mag = exp(step * lr), ang = step * li;
        const double er = mag * cos(ang) - 1.0, ei = mag * sin(ang); const double den = (lr * lr + li * li) * step;
        cof[2 * p] = (float)((er * lr + ei * li) / den); cof[2 * p + 1] = (float)((ei * lr - er * li) / den); }
    __syncthreads();
    for (int e = tid; e < 1024; e += 512) { const int p = e >> 4; const float cr = cof[2 * p], ci = cof[2 * p + 1]; const float br = b_re[e], bi = b_im[e];
        bbr[e] = cr * br - ci * bi; bbi[e] = cr * bi + ci * br; }
    __syncthreads();
    for (int e = tid; e < 4096; e += 512) { const int lag = e >> 8, c = (e >> 4) & 15, cp = e & 15; float s = 0.f;
        for (int p = 0; p < 64; ++p) { const float ar = apr[p * 17 + lag], ai = api[p * 17 + lag], br = bbr[p * 16 + cp], bi = bbi[p * 16 + cp];
            const float wr_ = ar * br - ai * bi, wi_ = ar * bi + ai * br; s += crs[c * 64 + p] * wr_ - cis[c * 64 + p] * wi_; }
        km[e] = s; }
    __syncthreads();
    h16* bt3 = (h16*)(P.ws + WS_BT3) + (size_t)(L * 64 + g) * 256 * 384;
    const float inv_step = (float)(1.0 / step);
    for (int e = tid; e < 256 * 384; e += 512) { const int n = e / 384, k = e % 384, t = n >> 4, c = n & 15; float v;
        if (k < 256) { const int s = k >> 4, cp = k & 15; v = (s <= t) ? km[((t - s) << 8) + (c << 4) + cp] : 0.f; if (s == t && c == cp) v += dsk[c] * inv_step; }
        else { const int kk = k - 256, p = kk & 63; const float ar = apr[p * 17 + t + 1], ai = api[p * 17 + t + 1], cr = crs[c * 64 + p], ci = cis[c * 64 + p];
            v = (kk < 64) ? (cr * ar - ci * ai) : -(cr * ai + ci * ar); }
        bt3[e] = (h16)v; }
    h16* bt1 = (h16*)(P.ws + WS_BT1) + (size_t)(L * 64 + g) * 256 * 256;
    for (int e = tid; e < 65536; e += 512) { const int n = e >> 8, k = e & 255, s = k >> 4, c = k & 15; float v = 0.f;
        if (n < 128) { const int p = n & 63; const float ar = apr[p * 17 + 15 - s], ai = api[p * 17 + 15 - s], br = bbr[p * 16 + c], bi = bbi[p * 16 + c];
            v = (n < 64) ? (ar * br - ai * bi) : (ar * bi + ai * br); }
        bt1[e] = (h16)v; }
    if (tid < 64) { const int p = tid; f32x2* a16 = (f32x2*)(P.ws + WS_A16) + (L * 64 + g) * 64; f32x2* asg = (f32x2*)(P.ws + WS_ASEG) + (L * 64 + g) * 64;
        a16[p] = (f32x2){apr[p * 17 + 16], api[p * 17 + 16]};
        const double mag = exp(2048.0 * step * (double)a_re[p]), ang = 2048.0 * step * (double)a_im[p]; asg[p] = (f32x2){(float)(mag * cos(ang)), (float)(mag * sin(ang))}; }
    if (tid == 0) ((float*)(P.ws + WS_STEP))[L * 64 + g] = (float)step;
    __syncthreads();
}

__device__ __forceinline__ void prep_phase(const Params& P, LAS unsigned char* lds) {
    const int tid = threadIdx.x, lane = tid & 63, wave = tid >> 6, G = gridDim.x;
    const int gw = blockIdx.x * 8 + wave, NGW = G * 8;
    for (int it = blockIdx.x; it < 128; it += G) ssm_prep_item(P, it >> 6, it & 63, lds);
    __syncthreads();
    { float* ss = (float*)(P.ws + WS_SUMSQ) + M_TOK; for (size_t i = (size_t)blockIdx.x * 512 + tid; i < (size_t)4 * M_TOK; i += (size_t)G * 512) ss[i] = 0.f; }
    { f32x2* rope = (f32x2*)(P.ws + WS_ROPE);
      for (int e = blockIdx.x * 512 + tid; e < SEQ * 32; e += G * 512) { const int l = e >> 5, i = e & 31; const float inv = (float)pow(10000.0, -(double)(2 * i) / 64.0); const float ang = (float)l * inv;
          rope[e] = (f32x2){(float)cos((double)ang), (float)sin((double)ang)}; } }
    LAS float* scr = (LAS float*)(lds + wave * 8704);
    constexpr int I_IN_S = 16 * 64, I_SQ = 16 * 32, I_IN_A = 16 * 72;
    constexpr int NITEMS = 2 * (I_IN_S + 2 * I_SQ) + 2 * (I_IN_A + I_SQ);
    unsigned char* ws = P.ws;
    for (int it = gw; it < NITEMS; it += NGW) {
        int r = it;
        if (r < I_IN_S) { transpose_item<0>(P.in[2], 1024, 2048, (h16*)(ws + W_IN0), P.in[1], scr, r, lane); continue; } r -= I_IN_S;
        if (r < I_SQ) { transpose_item<0>(P.in[11], 1024, 1024, (h16*)(ws + W_GLU0), nullptr, scr, r, lane); continue; } r -= I_SQ;
        if (r < I_SQ) { transpose_item<0>(P.in[13], 1024, 1024, (h16*)(ws + W_OUT0), nullptr, scr, r, lane); continue; } r -= I_SQ;
        if (r < I_IN_A) { transpose_item<1>(P.in[15], 1024, 2304, (h16*)(ws + W_IN1), P.in[14], scr, r, lane); continue; } r -= I_IN_A;
        if (r < I_SQ) { transpose_item<0>(P.in[17], 1024, 1024, (h16*)(ws + W_OUT1), nullptr, scr, r, lane); continue; } r -= I_SQ;
        if (r < I_IN_S) { transpose_item<0>(P.in[19], 1024, 2048, (h16*)(ws + W_IN2), P.in[18], scr, r, lane); continue; } r -= I_IN_S;
        if (r < I_SQ) { transpose_item<0>(P.in[28], 1024, 1024, (h16*)(ws + W_GLU2), nullptr, scr, r, lane); continue; } r -= I_SQ;
        if (r < I_SQ) { transpose_item<0>(P.in[30], 1024, 1024, (h16*)(ws + W_OUT2), nullptr, scr, r, lane); continue; } r -= I_SQ;
        if (r < I_IN_A) { transpose_item<1>(P.in[32], 1024, 2304, (h16*)(ws + W_IN3), P.in[31], scr, r, lane); continue; } r -= I_IN_A;
        transpose_item<0>(P.in[34], 1024, 1024, (h16*)(ws + W_OUT3), nullptr, scr, r, lane);
    }
    { const float* x = P.in[0]; h16* xh = (h16*)(ws + WS_XH); float* ss0 = (float*)(ws + WS_SUMSQ);
      for (int row = gw; row < M_TOK; row += NGW) { const f32x4* xr = (const f32x4*)(x + (size_t)row * DM) + lane; h4* o = (h4*)(xh + (size_t)row * DM) + lane; float s = 0.f;
#pragma unroll
          for (int j = 0; j < 4; ++j) { const f32x4 v = xr[64 * j]; s += (v[0] * v[0] + v[1] * v[1]) + (v[2] * v[2] + v[3] * v[3]); h4 hv; hv[0] = (h16)v[0]; hv[1] = (h16)v[1]; hv[2] = (h16)v[2]; hv[3] = (h16)v[3]; o[64 * j] = hv; }
          s = wave_sum(s); if (lane == 0) ss0[row] = s; } }
}

__device__ __forceinline__ void s2_phase(const Params& P, int L, LAS unsigned char* lds) {
    int tid = threadIdx.x; asm volatile("" : "+v"(tid));
    const int lane = tid & 63, wave = tid >> 6, seg = wave & 3;
    LAS f32x2* E = (LAS f32x2*)lds;
    for (int gb0 = blockIdx.x * 2; gb0 < 512; gb0 += gridDim.x * 2) {
        const int gb = gb0 + (wave >> 2), g = gb >> 3, b = gb & 7;
        const f32x2 a = ((const f32x2*)(P.ws + WS_A16))[(L * 64 + g) * 64 + lane];
        const f32x2 as = ((const f32x2*)(P.ws + WS_ASEG))[(L * 64 + g) * 64 + lane];
        const float* Gp = (const float*)(P.ws + WS_GP) + ((size_t)g * ROWS_G + b * 512 + seg * 128) * 128 + lane;
        float hr = 0.f, hi = 0.f;
        for (int n = 0; n < 128; n += 8) {
            float gr[8], gi[8];
#pragma unroll
            for (int j = 0; j < 8; ++j) { gr[j] = Gp[(size_t)(n + j) * 128]; gi[j] = Gp[(size_t)(n + j) * 128 + 64]; }
#pragma unroll
            for (int j = 0; j < 8; ++j) { const float t = a.x * hr - a.y * hi + gr[j]; hi = a.x * hi + a.y * hr + gi[j]; hr = t; }
        }
        E[wave * 64 + lane] = (f32x2){hr, hi};
        __syncthreads();
        float sr = 0.f, si = 0.f;
        for (int i = 0; i < seg; ++i) { const f32x2 e = E[((wave & ~3) + i) * 64 + lane]; const float t = as.x * sr - as.y * si + e.x; si = as.x * si + as.y * sr + e.y; sr = t; }
        h16* H = (h16*)(P.ws + WS_UH) + ((size_t)g * ROWS_G + b * 512 + seg * 128) * UHK + 256 + lane;
        hr = sr; hi = si;
        for (int n = 0; n < 128; n += 8) {
            float gr[8], gi[8];
#pragma unroll
            for (int j = 0; j < 8; ++j) { gr[j] = Gp[(size_t)(n + j) * 128]; gi[j] = Gp[(size_t)(n + j) * 128 + 64]; }
#pragma unroll
            for (int j = 0; j < 8; ++j) { H[(size_t)(n + j) * UHK] = (h16)hr; H[(size_t)(n + j) * UHK + 64] = (h16)hi;
                const float t = a.x * hr - a.y * hi + gr[j]; hi = a.x * hi + a.y * hr + gi[j]; hr = t; }
        }
        __syncthreads();
    }
}

__device__ __forceinline__ int crow(int r, int hi) { return (r & 3) + 8 * (r >> 2) + 4 * hi; }
__device__ __forceinline__ void attn_phase(const Params& P, int layer, LAS unsigned char* lds) {
    const h16* q = (const h16*)(P.ws + WS_UH); const h16* k = (const h16*)(P.ws + WS_K); const h16* vt = (const h16*)(P.ws + WS_VT);
    const h16* gate = (const h16*)(P.ws + WS_GATE); h16* og = (h16*)(P.ws + WS_OG);
    const float* sinks = P.in[layer == 1 ? 16 : 33];
    int tid = threadIdx.x; asm volatile("" : "+v"(tid));
    const int lane = tid & 63, wave = tid >> 6, l31 = lane & 31, hi = lane >> 5;
    LAS h16* Ks = (LAS h16*)lds;
    LAS h16* Vs = (LAS h16*)(lds + 256 * 144);
    for (int unit = blockIdx.x; unit < 1024; unit += gridDim.x) {
        const int kvh = unit & 1, blk = (unit >> 1) & 63, b = unit >> 7;
        __syncthreads();
#pragma unroll
        for (int i = 0; i < 4; ++i) { const int id = tid + 512 * i, key = id >> 3, part = id & 7; const int l = blk * 128 - 128 + key;
            h8 val = (h8)(h16)0.f; if (l >= 0) val = *(const h8*)(k + ((size_t)b * SEQ + l) * 128 + kvh * 64 + part * 8);
            *(LAS h8*)(Ks + key * 72 + part * 8) = val; }
#pragma unroll
        for (int i = 0; i < 4; ++i) { const int id = tid + 512 * i, d = id >> 5, part = id & 31; const int l0 = blk * 128 - 128 + part * 8;
            h8 val = (h8)(h16)0.f; if (l0 >= 0) val = *(const h8*)(vt + ((size_t)((b * 2 + kvh) * 64 + d)) * SEQ + l0);
            LAS h16* dst = Vs + d * 260 + part * 8; *(LAS h4*)dst = val.lo; *(LAS h4*)(dst + 4) = val.hi; }
        __syncthreads();
        const int hq = kvh * 8 + wave; const float sink2 = sinks[hq] * LOG2E;
        for (int i = 0; i < 4; ++i) {
            const size_t tok0 = (size_t)b * SEQ + blk * 128 + 32 * i;
            h8 qf[4];
#pragma unroll
            for (int ds = 0; ds < 4; ++ds) qf[ds] = *(const h8*)(q + (tok0 + l31) * DM + hq * 64 + 16 * ds + 8 * hi);
            f32x16 s[5];
#pragma unroll
            for (int t5 = 0; t5 < 5; ++t5) { f32x16 a16;
#pragma unroll
                for (int r = 0; r < 16; ++r) a16[r] = 0.f;
#pragma unroll
                for (int ds = 0; ds < 4; ++ds) { const h8 kf = *(const LAS h8*)(Ks + (32 * (i + t5) + l31) * 72 + 16 * ds + 8 * hi); a16 = __builtin_amdgcn_mfma_f32_32x32x16_f16(kf, qf[ds], a16, 0, 0, 0); }
                s[t5] = a16; }
            const int qi = 32 * i + l31;
            float mx = sink2;
#pragma unroll
            for (int t5 = 0; t5 < 5; ++t5)
#pragma unroll
                for (int r = 0; r < 16; ++r) { const int kj = 32 * (i + t5) + crow(r, hi); const bool valid = (kj > qi) && (kj <= qi + 128) && (blk > 0 || kj >= 128);
                    const float v = valid ? s[t5][r] : -1e30f; s[t5][r] = v; mx = fmaxf(mx, v); }
            mx = fmaxf(mx, __shfl_xor(mx, 32));
            float sum = 0.f;
#pragma unroll
            for (int t5 = 0; t5 < 5; ++t5)
#pragma unroll
                for (int r = 0; r < 16; ++r) { const float p = __builtin_amdgcn_exp2f(s[t5][r] - mx); s[t5][r] = p; sum += p; }
            sum += __shfl_xor(sum, 32);
            sum += __builtin_amdgcn_exp2f(sink2 - mx);
            const float inv = 1.0f / sum;
            f32x16 o0, o1;
#pragma unroll
            for (int r = 0; r < 16; ++r) { o0[r] = 0.f; o1[r] = 0.f; }
#pragma unroll
            for (int t5 = 0; t5 < 5; ++t5)
#pragma unroll
                for (int ss = 0; ss < 2; ++ss) { h8 pf;
#pragma unroll
                    for (int j = 0; j < 8; ++j) pf[j] = (h16)(s[t5][8 * ss + j] * inv);
                    const int kb = 32 * (i + t5) + 16 * ss + 4 * hi;
                    { const LAS h16* vp = Vs + l31 * 260 + kb; const h4 lo = *(const LAS h4*)vp, hi4 = *(const LAS h4*)(vp + 8);
                      const h8 vf = __builtin_shufflevector(lo, hi4, 0, 1, 2, 3, 4, 5, 6, 7); o0 = __builtin_amdgcn_mfma_f32_32x32x16_f16(pf, vf, o0, 0, 0, 0); }
                    { const LAS h16* vp = Vs + (32 + l31) * 260 + kb; const h4 lo = *(const LAS h4*)vp, hi4 = *(const LAS h4*)(vp + 8);
                      const h8 vf = __builtin_shufflevector(lo, hi4, 0, 1, 2, 3, 4, 5, 6, 7); o1 = __builtin_amdgcn_mfma_f32_32x32x16_f16(pf, vf, o1, 0, 0, 0); } }
#pragma unroll
            for (int r = 0; r < 16; ++r) { const size_t off = (tok0 + crow(r, hi)) * DM + hq * 64 + l31;
                const float g0 = (float)gate[off], g1 = (float)gate[off + 32];
                og[off] = (h16)(o0[r] * g0 * sigmoidf_(g0)); og[off + 32] = (h16)(o1[r] * g1 * sigmoidf_(g1)); }
        }
    }
}

__device__ __forceinline__ void final_norm_phase(const Params& P) {
    const int tid = threadIdx.x, lane = tid & 63, wave = tid >> 6; const int gw = blockIdx.x * 8 + wave, NGW = gridDim.x * 8;
    const float* ss = (const float*)(P.ws + WS_SUMSQ) + (size_t)4 * M_TOK; const f32x4* gn = (const f32x4*)P.in[35];
    f32x4 gv[4];
#pragma unroll
    for (int j = 0; j < 4; ++j) gv[j] = gn[64 * j + lane];
    for (int row = gw; row < M_TOK; row += NGW) { const float rs = rsqrtf(ss[row] * (1.0f / DM) + NORM_EPS); f32x4* xr = (f32x4*)(P.out + (size_t)row * DM) + lane;
#pragma unroll
        for (int j = 0; j < 4; ++j) { const f32x4 v = xr[64 * j]; xr[64 * j] = v * rs * gv[j]; } }
}

#ifndef PROBE_PHASE
#define PROBE_PHASE -1
#endif
#define PROBE_K 8
#define PB(id) do { if (PROBE_PHASE == (id) && layer < 2) pt0 = __builtin_amdgcn_s_memrealtime(); } while (0)
#define SYNC(id) do { grid.sync(); if (PROBE_PHASE == (id) && layer < 2 && blockIdx.x == 0) { const unsigned long long t1 = __builtin_amdgcn_s_memrealtime(); const unsigned long long dt = (t1 - pt0) * PROBE_K; \
    while (__builtin_amdgcn_s_memrealtime() - t1 < dt) __builtin_amdgcn_s_sleep(8); } } while (0)
constexpr int LDS_BYTES = 135168;
__global__ void __launch_bounds__(512) fwd_megakernel(Params P) {
    extern __shared__ __attribute__((aligned(16))) unsigned char lds_raw[];
    LAS unsigned char* lds = (LAS unsigned char*)lds_raw;
    cg::grid_group grid = cg::this_grid();
    const int G = gridDim.x, c = blockIdx.x;
    unsigned char* ws = P.ws;
    float* sumsq = (float*)(ws + WS_SUMSQ);
    h16* xh = (h16*)(ws + WS_XH); h16* UH = (h16*)(ws + WS_UH); float* Gp = (float*)(ws + WS_GP); h16* gate = (h16*)(ws + WS_GATE);
    h16* Zg = (h16*)(ws + WS_ZG); h16* og = (h16*)(ws + WS_OG);
    const AGeo plainA{2048u, 32u, 128};

#ifndef PH_MASK
#define PH_MASK 0xFFFF
#endif
    unsigned long long pt0 = 0;
    { const int layer = 0; PB(0); if (PH_MASK & 1) prep_phase(P, lds); SYNC(0); }

#pragma unroll 1
    for (int layer = 0; layer < 4; ++layer) {
        if ((layer & 1) == 0) {
            const int L = layer >> 1;
            const unsigned char* win = ws + (L ? W_IN2 : W_IN0); const unsigned char* wglu = ws + (L ? W_GLU2 : W_GLU0); const unsigned char* wout = ws + (L ? W_OUT2 : W_OUT0);
            const float* bglu = P.in[L ? 29 : 12];
            { PlainOrder S; S.init(M_TOK, 2048, G, c, xh, (size_t)256 * 2048, win, (size_t)256 * 2048);
              EpiG1Ssm E{sumsq + (size_t)layer * M_TOK, UH, gate};
              PB(1); if (PH_MASK & 2) gemm_phase(lds, plainA, 2048u, 16, S, E); }
            SYNC(1);
            { GroupOrder S{G, c, (const char*)UH, (const char*)(ws + WS_BT1) + (size_t)L * 64 * 256 * 256 * 2, (size_t)ROWS_G * UHK * 2, (size_t)256 * 256 * 2, (size_t)256 * UHK * 2};
              EpiS1 E{Gp};
              PB(2); if (PH_MASK & 4) gemm_phase(lds, AGeo{UHK * 2u, 32u, 128}, 512u, 4, S, E); }
            SYNC(2);
            PB(3); if (PH_MASK & 8) s2_phase(P, L, lds);
            SYNC(3);
            { GroupOrder S{G, c, (const char*)UH, (const char*)(ws + WS_BT3) + (size_t)L * 64 * 256 * 384 * 2, (size_t)ROWS_G * UHK * 2, (size_t)256 * 384 * 2, (size_t)256 * UHK * 2};
              EpiS3 E{(const float*)(ws + WS_STEP) + L * 64, Zg};
              PB(4); if (PH_MASK & 16) gemm_phase(lds, AGeo{UHK * 2u, 32u, 128}, 768u, 6, S, E); }
            SYNC(4);
            { PlainOrder S; S.init(M_TOK, 1024, G, c, Zg, (size_t)256 * 32, wglu, (size_t)256 * 2048);
              EpiGlu E{Zg, gate, bglu, og};
              PB(5); if (PH_MASK & 32) gemm_phase(lds, AGeo{32u, (unsigned)(M_TOK * 32), (size_t)4 * M_TOK * 32}, 2048u, 16, S, E); }
            SYNC(5);
            { PlainOrder S; S.init(M_TOK, 1024, G, c, og, (size_t)256 * 2048, wout, (size_t)256 * 2048);
              EpiOut<false> E{xh, P.out, sumsq + (size_t)(layer + 1) * M_TOK};
              PB(6); if (PH_MASK & 64) gemm_phase(lds, plainA, 2048u, 16, S, E); }
            SYNC(6);
        } else {
            const unsigned char* win = ws + (layer == 1 ? W_IN1 : W_IN3); const unsigned char* wout = ws + (layer == 1 ? W_OUT1 : W_OUT3);
            { PlainOrder S; S.init(M_TOK, 2304, G, c, xh, (size_t)256 * 2048, win, (size_t)256 * 2048);
              EpiG1Att E{sumsq + (size_t)layer * M_TOK, (const f32x2*)(ws + WS_ROPE), (h16*)(ws + WS_UH), (h16*)(ws + WS_K), (h16*)(ws + WS_VT), gate};
              PB(7); if (PH_MASK & 128) gemm_phase(lds, plainA, 2048u, 16, S, E); }
            SYNC(7);
            PB(8); if (PH_MASK & 256) attn_phase(P, layer, lds);
            SYNC(8);
            { PlainOrder S; S.init(M_TOK, 1024, G, c, og, (size_t)256 * 2048, wout, (size_t)256 * 2048);
              if (layer == 1) { EpiOut<false> E{xh, P.out, sumsq + (size_t)(layer + 1) * M_TOK};
                PB(9); if (PH_MASK & 512) gemm_phase(lds, plainA, 2048u, 16, S, E); }
              else { EpiOut<true> E{xh, P.out, sumsq + (size_t)(layer + 1) * M_TOK};
                if (PH_MASK & 512) gemm_phase(lds, plainA, 2048u, 16, S, E); } }
            SYNC(9);
        }
    }
    { const int layer = 0; PB(10); if (PH_MASK & 1024) final_norm_phase(P);
      if (PROBE_PHASE == 10 && blockIdx.x == 0) { const unsigned long long t1 = __builtin_amdgcn_s_memrealtime(); const unsigned long long dt = (t1 - pt0) * PROBE_K; while (__builtin_amdgcn_s_memrealtime() - t1 < dt) __builtin_amdgcn_s_sleep(8); } }
}

extern "C" void kernel_launch(void* const* d_in, const int* in_sizes, int n_in, void* d_out, int out_size, void* d_ws, size_t ws_size, hipStream_t stream) {
    static int grid_blocks = 0;
    if (grid_blocks == 0) {
        if (n_in != 36 || ws_size < WS_END) { fprintf(stderr, "kernel_launch: unexpected n_in %d / ws %zu\n", n_in, ws_size); grid_blocks = -1; return; }
        int dev = 0, cus = 0, per_cu = 0;
        hipGetDevice(&dev);
        hipDeviceGetAttribute(&cus, hipDeviceAttributeMultiprocessorCount, dev);
        hipFuncSetAttribute((const void*)fwd_megakernel, hipFuncAttributeMaxDynamicSharedMemorySize, LDS_BYTES);
        hipOccupancyMaxActiveBlocksPerMultiprocessor(&per_cu, (const void*)fwd_megakernel, 512, LDS_BYTES);
        if (per_cu < 1) per_cu = 1;
        grid_blocks = cus * per_cu;
        (void)hipGetLastError();
    }
    if (grid_blocks < 0) return;
    Params p{};
    for (int i = 0; i < 36; ++i) p.in[i] = (const float*)d_in[i];
    p.out = (float*)d_out; p.ws = (unsigned char*)d_ws;
    void* args[] = {&p};
    hipError_t e = hipLaunchCooperativeKernel((const void*)fwd_megakernel, dim3(grid_blocks), dim3(512), args, LDS_BYTES, stream);
    if (e != hipSuccess) fprintf(stderr, "cooperative launch failed: %s (grid %d)\n", hipGetErrorString(e), grid_blocks);
}
```

```cpp
#include <hip/hip_runtime.h>
#include <hip/hip_cooperative_groups.h>
#include <cstdint>
#include <cstdio>
namespace cg = cooperative_groups;

#define LAS __attribute__((address_space(3)))
typedef _Float16 h16;
typedef _Float16 h8 __attribute__((ext_vector_type(8)));
typedef _Float16 h4 __attribute__((ext_vector_type(4)));
typedef float f32x4 __attribute__((ext_vector_type(4)));
typedef float f32x2 __attribute__((ext_vector_type(2)));
typedef float f32x16 __attribute__((ext_vector_type(16)));

constexpr int M_TOK = 65536, DM = 1024, SEQ = 8192;
constexpr int ROWS_G = 4096;
constexpr int UHK = 384;
constexpr float NORM_EPS = 1e-5f;
constexpr float LOG2E = 1.4426950408889634f;

constexpr size_t MiB = 1u << 20;
constexpr size_t WS_SUMSQ = 0;
constexpr size_t WS_ROPE  = 2 * MiB;
constexpr size_t WS_A16   = 4 * MiB;
constexpr size_t WS_ASEG  = 4 * MiB + 65536;
constexpr size_t WS_STEP  = 4 * MiB + 131072;
constexpr size_t WS_W     = 8 * MiB;
constexpr size_t W_IN0 = WS_W, W_GLU0 = W_IN0 + 4 * MiB, W_OUT0 = W_GLU0 + 2 * MiB;
constexpr size_t W_IN1 = W_OUT0 + 2 * MiB, W_OUT1 = W_IN1 + 5 * MiB;
constexpr size_t W_IN2 = W_OUT1 + 2 * MiB, W_GLU2 = W_IN2 + 4 * MiB, W_OUT2 = W_GLU2 + 2 * MiB;
constexpr size_t W_IN3 = W_OUT2 + 2 * MiB, W_OUT3 = W_IN3 + 5 * MiB;
constexpr size_t WS_BT1 = 40 * MiB;
constexpr size_t WS_BT3 = 56 * MiB;
constexpr size_t WS_XH  = 80 * MiB;
constexpr size_t WS_UH  = 208 * MiB;
constexpr size_t WS_GP  = 400 * MiB;
constexpr size_t WS_K   = WS_GP, WS_VT = WS_GP + 32 * MiB;
constexpr size_t WS_GATE = 528 * MiB;
constexpr size_t WS_ZG  = 656 * MiB;
constexpr size_t WS_OG  = 784 * MiB;
constexpr size_t WS_END = 912 * MiB;

struct Params { const float* in[36]; float* out; unsigned char* ws; };

constexpr int BM = 256, BK = 64, HALF = 128, HTB = HALF * BK * 2, STAGE_BYTES = 8 * HTB, NXCD = 8, WGM = 8;
__device__ __forceinline__ int lds_byte(int r, int c) { const int st = (r >> 4) * 2 + (c >> 5), rr = r & 15, cc = c & 31, ob = rr * 64 + cc * 2; return st * 1024 + (ob ^ (((ob >> 9) & 1) << 5)); }
__device__ __forceinline__ void stage_rc(int b, int& R, int& C) { const int st = b / 1024, sb = b % 1024, swz = sb ^ (((sb >> 9) & 1) << 5); R = (st >> 1) * 16 + swz / 64; C = (st & 1) * 32 + (swz % 64) / 2; }
__device__ __forceinline__ int perm32(int rho) { const int n = rho >> 4, i = rho & 15; return 8 * (i >> 2) + 4 * n + (i & 3); }

struct GUnit { const char* a; const char* b; int pm, pn, g; };
struct AGeo { unsigned lda, slab; size_t kstep; };

struct PlainOrder {
    int nM, nN, nwg, G, c; const char* A; const char* B; size_t ta, tb;
    __device__ __forceinline__ void init(int M, int N, int G_, int c_, const void* A_, size_t ta_, const void* B_, size_t tb_) { nM = M / BM; nN = N / BM; nwg = nM * nN; G = G_; c = c_; A = (const char*)A_; B = (const char*)B_; ta = ta_; tb = tb_; }
    __device__ __forceinline__ bool next(int i, GUnit& u) const {
        const long L = (long)i * G + c; if (L >= nwg) return false;
        int wgid = (int)L; { const int q = nwg / NXCD, r = nwg % NXCD, xcd = wgid % NXCD, off = wgid / NXCD; wgid = (xcd < r ? xcd * (q + 1) : r * (q + 1) + (xcd - r) * q) + off; }
        const int nig = WGM * nN, gid = wgid / nig, fm = gid * WGM, gsz = (nM - fm) < WGM ? (nM - fm) : WGM;
        u.pm = fm + ((wgid % nig) % gsz); u.pn = (wgid % nig) / gsz; u.g = 0;
        u.a = A + (size_t)u.pm * ta; u.b = B + (size_t)u.pn * tb; return true;
    }
};
struct GroupOrder {
    int G, c; const char* A; const char* B; size_t gsa, gsb, ta;
    __device__ __forceinline__ bool next(int i, GUnit& u) const {
        const long L = (long)i * G + c; if (L >= 1024) return false;
        int g, pm;
        if (G == 256) { const int xcd = c & 7, j = c >> 3; g = i * 16 + xcd * 2 + (j >> 4); pm = j & 15; }
        else { g = (int)(L >> 4); pm = (int)(L & 15); }
        u.g = g; u.pm = pm; u.pn = 0; u.a = A + (size_t)g * gsa + (size_t)pm * ta; u.b = B + (size_t)g * gsb; return true;
    }
};

template <class Epi, class Sched>
__device__ __forceinline__ void gemm_phase(LAS unsigned char* lds, const AGeo ga, const unsigned ldb, const int nt, const Sched& S, const Epi& E) {
    int tid = threadIdx.x; asm volatile("" : "+v"(tid));
    const int wid = __builtin_amdgcn_readfirstlane(tid >> 6), lane = tid & 63, wr = wid >> 2, wc = wid & 3, fr = lane & 15, fq = lane >> 4;
    unsigned voffA[2], voffB[2];
#pragma unroll
    for (int i = 0; i < 2; ++i) { int R, C; stage_rc(tid * 16 + i * 8192, R, C); const int Rb = (R & ~31) + perm32(R & 31);
        voffA[i] = (unsigned)R * ga.lda + (unsigned)(C >> 4) * ga.slab + (unsigned)(C & 15) * 2u; voffB[i] = (unsigned)Rb * ldb + (unsigned)C * 2u; }
    const size_t kA = ga.kstep, kB = 128;
    const size_t hA = (size_t)HALF * ga.lda, hB = (size_t)HALF * ldb;
    const unsigned ldsw = (unsigned)wid * 1024u;
    const int aoff = lds_byte(wr * 64 + fr, fq * 8), boff = lds_byte(wc * 32 + fr, fq * 8);
#define PG8_SA(b, h) (((b) * 2 + (h)) * HTB)
#define PG8_SB(b, h) ((4 + (b) * 2 + (h)) * HTB)
#define PG8_STAGE(bufoff, gbase, voff) do { _Pragma("unroll") for (int _i = 0; _i < 2; ++_i) \
        __builtin_amdgcn_global_load_lds((const unsigned*)((const char*)(gbase) + (voff)[_i]), (LAS unsigned*)(lds + (bufoff) + ldsw + _i * 8192), 16, 0, 0); } while (0)
#define PG8_LDA(dst, b, h) do { _Pragma("unroll") for (int m = 0; m < 4; ++m) _Pragma("unroll") for (int k = 0; k < 2; ++k) dst[m][k] = *(const LAS h8*)(lds + PG8_SA(b, h) + aoff + m * 2048 + k * 1024); } while (0)
#define PG8_LDB(dst, b, h) do { _Pragma("unroll") for (int n = 0; n < 2; ++n) _Pragma("unroll") for (int k = 0; k < 2; ++k) dst[n][k] = *(const LAS h8*)(lds + PG8_SB(b, h) + boff + n * 2048 + k * 1024); } while (0)
#define PG8_MMA(ai, bj, At, Bt) do { __builtin_amdgcn_s_setprio(1); _Pragma("unroll") for (int m = 0; m < 4; ++m) _Pragma("unroll") for (int n = 0; n < 2; ++n) _Pragma("unroll") for (int k = 0; k < 2; ++k) \
        acc[ai][bj][m][n] = __builtin_amdgcn_mfma_f32_16x16x32_f16(Bt[n][k], At[m][k], acc[ai][bj][m][n], 0, 0, 0); __builtin_amdgcn_s_setprio(0); } while (0)
#define PG8_WAIT_V(n) asm volatile("s_waitcnt vmcnt(" #n ")" ::: "memory")
#define PG8_WAIT_L(n) asm volatile("s_waitcnt lgkmcnt(" #n ")" ::: "memory")
#define PG8_BAR __builtin_amdgcn_s_barrier()
#define PG8_SCHED __builtin_amdgcn_sched_barrier(0)
    GUnit cur, nxt; int ui = 0;
    if (!S.next(0, cur)) return;
    f32x4 acc[2][2][4][2];
#pragma unroll
    for (int a = 0; a < 2; ++a)
#pragma unroll
        for (int b = 0; b < 2; ++b)
#pragma unroll
            for (int m = 0; m < 4; ++m)
#pragma unroll
                for (int n = 0; n < 2; ++n) acc[a][b][m][n] = (f32x4){0.f, 0.f, 0.f, 0.f};
    h8 At[4][2], B0[2][2], B1[2][2];
    const char* cA = cur.a; const char* cB = cur.b;
    PG8_STAGE(PG8_SB(0, 0), cB, voffB); PG8_STAGE(PG8_SB(0, 1), cB + hB, voffB); PG8_STAGE(PG8_SA(0, 0), cA, voffA); PG8_STAGE(PG8_SA(0, 1), cA + hA, voffA);
    if (wr == 1) PG8_BAR;
    PG8_WAIT_V(2); PG8_BAR;
    PG8_STAGE(PG8_SB(1, 0), cB + kB, voffB); PG8_STAGE(PG8_SA(1, 0), cA + kA, voffA); PG8_STAGE(PG8_SB(1, 1), cB + hB + kB, voffB);
    PG8_WAIT_V(6); PG8_BAR;
    for (;;) {
        const bool has_next = S.next(ui + 1, nxt);
        const char* nA = has_next ? nxt.a : cA; const char* nB = has_next ? nxt.b : cB;
#pragma unroll 1
        for (int t = 0; t < nt; t += 2) {
            const bool last = (t == nt - 2);
            const char* a1 = cA + (size_t)(t + 1) * kA;
            const char* a2 = last ? nA : cA + (size_t)(t + 2) * kA; const char* b2 = last ? nB : cB + (size_t)(t + 2) * kB;
            const char* a3 = a2 + kA; const char* b3 = b2 + kB;
            PG8_LDB(B0, 0, 0); PG8_LDB(B1, 0, 1); PG8_SCHED; PG8_LDA(At, 0, 0); PG8_STAGE(PG8_SA(1, 1), a1 + hA, voffA);
            PG8_WAIT_V(8); PG8_WAIT_L(0); PG8_BAR; PG8_MMA(0, 0, At, B0); PG8_MMA(0, 1, At, B1); PG8_BAR; PG8_SCHED;
            PG8_LDA(At, 0, 1); PG8_STAGE(PG8_SB(0, 0), b2, voffB); PG8_STAGE(PG8_SB(0, 1), b2 + hB, voffB); PG8_STAGE(PG8_SA(0, 0), a2, voffA);
            PG8_WAIT_V(8); PG8_WAIT_L(0); PG8_BAR; PG8_MMA(1, 0, At, B0); PG8_MMA(1, 1, At, B1); PG8_BAR; PG8_SCHED;
            PG8_LDB(B0, 1, 0); PG8_LDB(B1, 1, 1); PG8_SCHED; PG8_LDA(At, 1, 0); PG8_STAGE(PG8_SA(0, 1), a2 + hA, voffA);
            PG8_WAIT_V(8); PG8_WAIT_L(0); PG8_BAR; PG8_MMA(0, 0, At, B0); PG8_MMA(0, 1, At, B1); PG8_BAR; PG8_SCHED;
            PG8_LDA(At, 1, 1); PG8_STAGE(PG8_SB(1, 0), b3, voffB); PG8_STAGE(PG8_SB(1, 1), b3 + hB, voffB); PG8_STAGE(PG8_SA(1, 0), a3, voffA);
            PG8_WAIT_V(8); PG8_WAIT_L(0); PG8_BAR; PG8_MMA(1, 0, At, B0); PG8_MMA(1, 1, At, B1); PG8_BAR; PG8_SCHED;
        }
        if (wr == 0) PG8_BAR;
        E(acc, cur, wr, wc, fr, fq);
        if (!has_next) break;
#pragma unroll
        for (int a = 0; a < 2; ++a)
#pragma unroll
            for (int b = 0; b < 2; ++b)
#pragma unroll
                for (int m = 0; m < 4; ++m)
#pragma unroll
                    for (int n = 0; n < 2; ++n) acc[a][b][m][n] = (f32x4){0.f, 0.f, 0.f, 0.f};
        cur = nxt; cA = nA; cB = nB; ++ui;
        if (wr == 1) PG8_BAR;
    }
    PG8_WAIT_V(0);
    PG8_BAR;
#undef PG8_SA
#undef PG8_SB
#undef PG8_STAGE
#undef PG8_LDA
#undef PG8_LDB
#undef PG8_MMA
#undef PG8_WAIT_V
#undef PG8_WAIT_L
#undef PG8_BAR
#undef PG8_SCHED
}

__device__ __forceinline__ h8 pack8(f32x4 a, f32x4 b) { h8 r; r[0] = (h16)a[0]; r[1] = (h16)a[1]; r[2] = (h16)a[2]; r[3] = (h16)a[3]; r[4] = (h16)b[0]; r[5] = (h16)b[1]; r[6] = (h16)b[2]; r[7] = (h16)b[3]; return r; }
__device__ __forceinline__ float sigmoidf_(float x) { return __builtin_amdgcn_rcpf(1.0f + __expf(-x)); }

struct EpiG1Ssm {
    const float* sumsq; h16* UH; h16* gate;
    __device__ __forceinline__ void operator()(const f32x4 (&acc)[2][2][4][2], const GUnit& u, int wr, int wc, int fr, int fq) const {
#pragma unroll
        for (int ai = 0; ai < 2; ++ai)
#pragma unroll
            for (int m = 0; m < 4; ++m) {
                const int row = u.pm * BM + ai * HALF + wr * 64 + m * 16 + fr;
                const float rs = rsqrtf(sumsq[row] * (1.0f / DM) + NORM_EPS);
#pragma unroll
                for (int bj = 0; bj < 2; ++bj) {
                    const int ch0 = u.pn * BM + bj * HALF + wc * 32 + 8 * fq;
                    const h8 v = pack8(acc[ai][bj][m][0] * rs, acc[ai][bj][m][1] * rs);
                    if (ch0 < 1024) { const int g = ch0 >> 4, c0 = ch0 & 15;
                        *(h8*)(UH + ((size_t)g * ROWS_G + (row >> 4)) * UHK + (row & 15) * 16 + c0) = v; }
                    else *(h8*)(gate + (size_t)row * DM + (ch0 - 1024)) = v;
                }
            }
    }
};
struct EpiS1 {
    float* Gp;
    __device__ __forceinline__ void operator()(const f32x4 (&acc)[2][2][4][2], const GUnit& u, int wr, int wc, int fr, int fq) const {
#pragma unroll
        for (int ai = 0; ai < 2; ++ai)
#pragma unroll
            for (int m = 0; m < 4; ++m) {
                const int row = u.pm * BM + ai * HALF + wr * 64 + m * 16 + fr;
                float* p = Gp + ((size_t)u.g * ROWS_G + row) * 128 + wc * 32 + 8 * fq;
                *(f32x4*)p = acc[ai][0][m][0]; *(f32x4*)(p + 4) = acc[ai][0][m][1];
            }
    }
};
struct EpiS3 {
    const float* stepv; h16* Zg;
    static __device__ __forceinline__ float gelu1(float a) { return a * __builtin_amdgcn_rcpf(1.0f + __expf(-1.5957691216f * (a + 0.044715f * a * a * a))); }
    __device__ __forceinline__ void operator()(const f32x4 (&acc)[2][2][4][2], const GUnit& u, int wr, int wc, int fr, int fq) const {
        const float st = stepv[u.g];
        h16* base = Zg + (size_t)u.g * M_TOK * 16 + (size_t)(u.pm * BM + wr * 64 + fr) * 256 + wc * 32 + 8 * fq;
#pragma unroll
        for (int ai = 0; ai < 2; ++ai)
#pragma unroll
            for (int m = 0; m < 4; ++m) {
#pragma unroll
                for (int bj = 0; bj < 2; ++bj) {
                    const f32x4 y0 = acc[ai][bj][m][0] * st, y1 = acc[ai][bj][m][1] * st;
                    h8 o;
#pragma unroll
                    for (int j = 0; j < 4; ++j) { o[j] = (h16)gelu1(y0[j]); o[4 + j] = (h16)gelu1(y1[j]); }
                    *(h8*)(base + (size_t)(ai * HALF + m * 16) * 256 + bj * HALF) = o;
                    __builtin_amdgcn_sched_barrier(0);
                }
            }
    }
};
struct EpiGlu {
    const h16* Zg; const h16* gate; const float* bias; h16* og;
    __device__ __forceinline__ void operator()(const f32x4 (&acc)[2][2][4][2], const GUnit& u, int wr, int wc, int fr, int fq) const {
#pragma unroll
        for (int bj = 0; bj < 2; ++bj) {
            const int n0 = u.pn * BM + bj * HALF + wc * 32 + 8 * fq;
            const f32x4 b0 = *(const f32x4*)(bias + n0), b1 = *(const f32x4*)(bias + n0 + 4);
#pragma unroll
            for (int ai = 0; ai < 2; ++ai)
#pragma unroll
                for (int m = 0; m < 4; ++m) {
                    const int row = u.pm * BM + ai * HALF + wr * 64 + m * 16 + fr;
                    const h8 z = *(const h8*)(Zg + ((size_t)(n0 >> 4) * M_TOK + row) * 16 + (n0 & 15));
                    const h8 gt = *(const h8*)(gate + (size_t)row * DM + n0);
                    const f32x4 a0 = acc[ai][bj][m][0] + b0, a1 = acc[ai][bj][m][1] + b1;
                    h8 o;
#pragma unroll
                    for (int j = 0; j < 4; ++j) {
                        const float g0 = (float)gt[j], g1 = (float)gt[4 + j];
                        o[j] = (h16)((float)z[j] * sigmoidf_(a0[j]) * g0 * sigmoidf_(g0));
                        o[4 + j] = (h16)((float)z[4 + j] * sigmoidf_(a1[j]) * g1 * sigmoidf_(g1));
                    }
                    *(h8*)(og + (size_t)row * DM + n0) = o;
                }
        }
    }
};
template <bool LAST>
struct EpiOut {
    h16* xh; float* xout; float* sumsq;
    __device__ __forceinline__ void operator()(const f32x4 (&acc)[2][2][4][2], const GUnit& u, int wr, int wc, int fr, int fq) const {
#pragma unroll
        for (int ai = 0; ai < 2; ++ai)
#pragma unroll
            for (int m = 0; m < 4; ++m) {
                const int row = u.pm * BM + ai * HALF + wr * 64 + m * 16 + fr;
                float ss = 0.f;
#pragma unroll
                for (int bj = 0; bj < 2; ++bj) {
                    const size_t off = (size_t)row * DM + u.pn * BM + bj * HALF + wc * 32 + 8 * fq;
                    const h8 xo = *(const h8*)(xh + off);
                    f32x4 v0, v1;
#pragma unroll
                    for (int j = 0; j < 4; ++j) { v0[j] = (float)xo[j] + acc[ai][bj][m][0][j]; v1[j] = (float)xo[4 + j] + acc[ai][bj][m][1][j]; }
                    if (LAST) { *(f32x4*)(xout + off) = v0; *(f32x4*)(xout + off + 4) = v1; }
                    else { const h8 xn = pack8(v0, v1); *(h8*)(xh + off) = xn;
#pragma unroll
                        for (int j = 0; j < 4; ++j) { v0[j] = (float)xn[j]; v1[j] = (float)xn[4 + j]; } }
                    ss += (v0[0] * v0[0] + v0[1] * v0[1]) + (v0[2] * v0[2] + v0[3] * v0[3]) + (v1[0] * v1[0] + v1[1] * v1[1]) + (v1[2] * v1[2] + v1[3] * v1[3]);
                }
                ss += __shfl_xor(ss, 16); ss += __shfl_xor(ss, 32);
                if (fq == 0) atomicAdd(sumsq + row, ss);
            }
    }
};
struct EpiG1Att {
    const float* sumsq; const f32x2* rope; h16* q; h16* k; h16* vt; h16* gate;
    __device__ __forceinline__ void operator()(const f32x4 (&acc)[2][2][4][2], const GUnit& u, int wr, int wc, int fr, int fq) const {
#pragma unroll
        for (int ai = 0; ai < 2; ++ai)
#pragma unroll
            for (int m = 0; m < 4; ++m) {
                const int row = u.pm * BM + ai * HALF + wr * 64 + m * 16 + fr;
                const int l = row & (SEQ - 1);
                const float rs = rsqrtf(sumsq[row] * (1.0f / DM) + NORM_EPS);
#pragma unroll
                for (int bj = 0; bj < 2; ++bj) {
                    const int ct = bj * HALF + wc * 32 + 8 * fq;
                    f32x4 v0 = acc[ai][bj][m][0] * rs, v1 = acc[ai][bj][m][1] * rs;
                    if (u.pn < 4 || (u.pn == 4 && bj == 0)) {
                        const int i0 = (ct & 63) >> 1;
                        const f32x2 cs0 = rope[l * 32 + i0], cs1 = rope[l * 32 + i0 + 1], cs2 = rope[l * 32 + i0 + 2], cs3 = rope[l * 32 + i0 + 3];
                        const float sc = (u.pn < 4) ? 0.125f * LOG2E : 1.0f;
                        f32x4 r0, r1;
                        r0[0] = (v0[0] * cs0.x - v0[1] * cs0.y) * sc; r0[1] = (v0[1] * cs0.x + v0[0] * cs0.y) * sc;
                        r0[2] = (v0[2] * cs1.x - v0[3] * cs1.y) * sc; r0[3] = (v0[3] * cs1.x + v0[2] * cs1.y) * sc;
                        r1[0] = (v1[0] * cs2.x - v1[1] * cs2.y) * sc; r1[1] = (v1[1] * cs2.x + v1[0] * cs2.y) * sc;
                        r1[2] = (v1[2] * cs3.x - v1[3] * cs3.y) * sc; r1[3] = (v1[3] * cs3.x + v1[2] * cs3.y) * sc;
                        const h8 o = pack8(r0, r1);
                        if (u.pn < 4) *(h8*)(q + (size_t)row * DM + u.pn * BM + ct) = o;
                        else *(h8*)(k + (size_t)row * 128 + ct) = o;
                    } else if (u.pn == 4) {
                        const int vc = ct - 128, kvh = vc >> 6, d0 = vc & 63, b = row >> 13;
                        h16* dst = vt + ((size_t)((b * 2 + kvh) * 64 + d0)) * SEQ + l;
#pragma unroll
                        for (int j = 0; j < 4; ++j) { dst[(size_t)j * SEQ] = (h16)v0[j]; dst[(size_t)(4 + j) * SEQ] = (h16)v1[j]; }
                    } else {
                        *(h8*)(gate + (size_t)row * DM + (u.pn - 5) * BM + ct) = pack8(v0, v1);
                    }
                }
            }
    }
};

__device__ __forceinline__ float wave_sum(float v) {
#pragma unroll
    for (int o = 1; o < 64; o <<= 1) v += __shfl_xor(v, o);
    return v;
}
template <int MODE>
__device__ __forceinline__ void transpose_item(const float* W, int K, int N, h16* WT, const float* gsc, LAS float* scr, int item, int lane) {
    const int nblk = N / 32, kb = item / nblk, nb = item % nblk, k0 = 64 * kb, n0 = 32 * nb;
    const int nd = n0 + (lane & 31); int src = nd;
    if (MODE == 1 && nd < 1152) { const int j = nd & 63; src = (nd & ~63) + (j >> 1) + 32 * (j & 1); }
#pragma unroll 8
    for (int i = 0; i < 32; ++i) { const int kk = 2 * i + (lane >> 5); float v = W[(size_t)(k0 + kk) * N + src]; if (gsc) v *= gsc[k0 + kk]; scr[kk * 33 + (lane & 31)] = v; }
    asm volatile("s_waitcnt lgkmcnt(0)" ::: "memory");
    const int c = lane & 7;
#pragma unroll
    for (int j = 0; j < 4; ++j) { const int n = (lane >> 3) + 8 * j; const LAS float* s = scr + (8 * c) * 33 + n;
        h8 o; o[0] = (h16)s[0 * 33]; o[1] = (h16)s[1 * 33]; o[2] = (h16)s[2 * 33]; o[3] = (h16)s[3 * 33]; o[4] = (h16)s[4 * 33]; o[5] = (h16)s[5 * 33]; o[6] = (h16)s[6 * 33]; o[7] = (h16)s[7 * 33];
        *(h8*)(WT + (size_t)(n0 + n) * K + k0 + 8 * c) = o; }
    asm volatile("s_waitcnt lgkmcnt(0)" ::: "memory");
}

__device__ __forceinline__ void ssm_prep_item(const Params& P, int L, int g, LAS unsigned char* lds) {
    const int base = (L == 0) ? 1 : 18;
    const float* a_re = P.in[base + 2] + g * 64; const float* a_im = P.in[base + 3] + g * 64; const float* log_step = P.in[base + 4];
    const float* b_re = P.in[base + 5] + g * 1024; const float* b_im = P.in[base + 6] + g * 1024;
    const float* c_re = P.in[base + 7] + g * 1024; const float* c_im = P.in[base + 8] + g * 1024;
    const float* dsk = P.in[base + 9] + g * 16;
    LAS float* apr = (LAS float*)lds;
    LAS float* api = apr + 64 * 17;
    LAS float* bbr = api + 64 * 17;
    LAS float* bbi = bbr + 1024;
    LAS float* km = bbi + 1024;
    LAS float* crs = km + 4096;
    LAS float* cis = crs + 1024;
    LAS float* cof = cis + 1024;
    const int tid = threadIdx.x;
    const double step = exp((double)log_step[g]);
    for (int e = tid; e < 1024; e += 512) { crs[e] = c_re[e]; cis[e] = c_im[e]; }
    for (int e = tid; e < 64 * 17; e += 512) { const int p = e / 17, k = e % 17; const double mag = exp((double)k * step * (double)a_re[p]), ang = (double)k * step * (double)a_im[p];
        apr[e] = (float)(mag * cos(ang)); api[e] = (float)(mag * sin(ang)); }
    if (tid < 64) { const int p = tid; const double lr = a_re[p], li = a_im[p]; const double mag = exp(step * lr), ang = step * li;
        const double er = mag * cos(ang) - 1.0, ei = mag * sin(ang); const double den = (lr * lr + li * li) * step;
        cof[2 * p] = (float)((er * lr + ei * li) / den); cof[2 * p + 1] = (float)((ei * lr - er * li) / den); }
    __syncthreads();
    for (int e = tid; e < 1024; e += 512) { const int p = e >> 4; const float cr = cof[2 * p], ci = cof[2 * p + 1]; const float br = b_re[e], bi = b_im[e];
        bbr[e] = cr * br - ci * bi; bbi[e] = cr * bi + ci * br; }
    __syncthreads();
    for (int e = tid; e < 4096; e += 512) { const int lag = e >> 8, c = (e >> 4) & 15, cp = e & 15; float s = 0.f;
        for (int p = 0; p < 64; ++p) { const float ar = apr[p * 17 + lag], ai = api[p * 17 + lag], br = bbr[p * 16 + cp], bi = bbi[p * 16 + cp];
            const float wr_ = ar * br - ai * bi, wi_ = ar * bi + ai * br; s += crs[c * 64 + p] * wr_ - cis[c * 64 + p] * wi_; }
        km[e] = s; }
    __syncthreads();
    h16* bt3 = (h16*)(P.ws + WS_BT3) + (size_t)(L * 64 + g) * 256 * 384;
    const float inv_step = (float)(1.0 / step);
    for (int e = tid; e < 256 * 384; e += 512) { const int n = e / 384, k = e % 384, t = n >> 4, c = n & 15; float v;
        if (k < 256) { const int s = k >> 4, cp = k & 15; v = (s <= t) ? km[((t - s) << 8) + (c << 4) + cp] : 0.f; if (s == t && c == cp) v += dsk[c] * inv_step; }
        else { const int kk = k - 256, p = kk & 63; const float ar = apr[p * 17 + t + 1], ai = api[p * 17 + t + 1], cr = crs[c * 64 + p], ci = cis[c * 64 + p];
            v = (kk < 64) ? (cr * ar - ci * ai) : -(cr * ai + ci * ar); }
        bt3[e] = (h16)v; }
    h16* bt1 = (h16*)(P.ws + WS_BT1) + (size_t)(L * 64 + g) * 256 * 256;
    for (int e = tid; e < 65536; e += 512) { const int n = e >> 8, k = e & 255, s = k >> 4, c = k & 15; float v = 0.f;
        if (n < 128) { const int p = n & 63; const float ar = apr[p * 17 + 15 - s], ai = api[p * 17 + 15 - s], br = bbr[p * 16 + c], bi = bbi[p * 16 + c];
            v = (n < 64) ? (ar * br - ai * bi) : (ar * bi + ai * br); }
        bt1[e] = (h16)v; }
    if (tid < 64) { const int p = tid; f32x2* a16 = (f32x2*)(P.ws + WS_A16) + (L * 64 + g) * 64; f32x2* asg = (f32x2*)(P.ws + WS_ASEG) + (L * 64 + g) * 64;
        a16[p] = (f32x2){apr[p * 17 + 16], api[p * 17 + 16]};
        const double mag = exp(2048.0 * step * (double)a_re[p]), ang = 2048.0 * step * (double)a_im[p]; asg[p] = (f32x2){(float)(mag * cos(ang)), (float)(mag * sin(ang))}; }
    if (tid == 0) ((float*)(P.ws + WS_STEP))[L * 64 + g] = (float)step;
    __syncthreads();
}

__device__ __forceinline__ void prep_phase(const Params& P, LAS unsigned char* lds) {
    int tid = threadIdx.x; asm volatile("" : "+v"(tid));
    const int lane = tid & 63, wave = tid >> 6, G = gridDim.x;
    const int gw = blockIdx.x * 8 + wave, NGW = G * 8;
    for (int it = blockIdx.x; it < 128; it += G) ssm_prep_item(P, it >> 6, it & 63, lds);
    __syncthreads();
    { float* ss = (float*)(P.ws + WS_SUMSQ) + M_TOK; for (size_t i = (size_t)blockIdx.x * 512 + tid; i < (size_t)4 * M_TOK; i += (size_t)G * 512) ss[i] = 0.f; }
    { f32x2* rope = (f32x2*)(P.ws + WS_ROPE);
      for (int e = blockIdx.x * 512 + tid; e < SEQ * 32; e += G * 512) { const int l = e >> 5, i = e & 31; const float inv = (float)pow(10000.0, -(double)(2 * i) / 64.0); const float ang = (float)l * inv;
          rope[e] = (f32x2){(float)cos((double)ang), (float)sin((double)ang)}; } }
    LAS float* scr = (LAS float*)(lds + wave * 8704);
    constexpr int I_IN_S = 16 * 64, I_SQ = 16 * 32, I_IN_A = 16 * 72;
    constexpr int NITEMS = 2 * (I_IN_S + 2 * I_SQ) + 2 * (I_IN_A + I_SQ);
    unsigned char* ws = P.ws;
    for (int it = gw; it < NITEMS; it += NGW) {
        int r = it;
        if (r < I_IN_S) { transpose_item<0>(P.in[2], 1024, 2048, (h16*)(ws + W_IN0), P.in[1], scr, r, lane); continue; } r -= I_IN_S;
        if (r < I_SQ) { transpose_item<0>(P.in[11], 1024, 1024, (h16*)(ws + W_GLU0), nullptr, scr, r, lane); continue; } r -= I_SQ;
        if (r < I_SQ) { transpose_item<0>(P.in[13], 1024, 1024, (h16*)(ws + W_OUT0), nullptr, scr, r, lane); continue; } r -= I_SQ;
        if (r < I_IN_A) { transpose_item<1>(P.in[15], 1024, 2304, (h16*)(ws + W_IN1), P.in[14], scr, r, lane); continue; } r -= I_IN_A;
        if (r < I_SQ) { transpose_item<0>(P.in[17], 1024, 1024, (h16*)(ws + W_OUT1), nullptr, scr, r, lane); continue; } r -= I_SQ;
        if (r < I_IN_S) { transpose_item<0>(P.in[19], 1024, 2048, (h16*)(ws + W_IN2), P.in[18], scr, r, lane); continue; } r -= I_IN_S;
        if (r < I_SQ) { transpose_item<0>(P.in[28], 1024, 1024, (h16*)(ws + W_GLU2), nullptr, scr, r, lane); continue; } r -= I_SQ;
        if (r < I_SQ) { transpose_item<0>(P.in[30], 1024, 1024, (h16*)(ws + W_OUT2), nullptr, scr, r, lane); continue; } r -= I_SQ;
        if (r < I_IN_A) { transpose_item<1>(P.in[32], 1024, 2304, (h16*)(ws + W_IN3), P.in[31], scr, r, lane); continue; } r -= I_IN_A;
        transpose_item<0>(P.in[34], 1024, 1024, (h16*)(ws + W_OUT3), nullptr, scr, r, lane);
    }
    { const float* x = P.in[0]; h16* xh = (h16*)(ws + WS_XH); float* ss0 = (float*)(ws + WS_SUMSQ);
      for (int row = gw; row < M_TOK; row += NGW) { const f32x4* xr = (const f32x4*)(x + (size_t)row * DM) + lane; h4* o = (h4*)(xh + (size_t)row * DM) + lane; float s = 0.f;
#pragma unroll
          for (int j = 0; j < 4; ++j) { const f32x4 v = xr[64 * j]; s += (v[0] * v[0] + v[1] * v[1]) + (v[2] * v[2] + v[3] * v[3]); h4 hv; hv[0] = (h16)v[0]; hv[1] = (h16)v[1]; hv[2] = (h16)v[2]; hv[3] = (h16)v[3]; o[64 * j] = hv; }
          s = wave_sum(s); if (lane == 0) ss0[row] = s; } }
}

__device__ __forceinline__ void s2_phase(const Params& P, int L, LAS unsigned char* lds) {
    int tid = threadIdx.x; asm volatile("" : "+v"(tid));
    const int lane = tid & 63, wave = tid >> 6, seg = wave & 3;
    LAS f32x2* E = (LAS f32x2*)lds;
    for (int gb0 = blockIdx.x * 2; gb0 < 512; gb0 += gridDim.x * 2) {
        const int gb = gb0 + (wave >> 2), g = gb >> 3, b = gb & 7;
        const f32x2 a = ((const f32x2*)(P.ws + WS_A16))[(L * 64 + g) * 64 + lane];
        const f32x2 as = ((const f32x2*)(P.ws + WS_ASEG))[(L * 64 + g) * 64 + lane];
        const float* Gp = (const float*)(P.ws + WS_GP) + ((size_t)g * ROWS_G + b * 512 + seg * 128) * 128 + lane;
        float hr = 0.f, hi = 0.f;
        for (int n = 0; n < 128; n += 8) {
            float gr[8], gi[8];
#pragma unroll
            for (int j = 0; j < 8; ++j) { gr[j] = Gp[(size_t)(n + j) * 128]; gi[j] = Gp[(size_t)(n + j) * 128 + 64]; }
#pragma unroll
            for (int j = 0; j < 8; ++j) { const float t = a.x * hr - a.y * hi + gr[j]; hi = a.x * hi + a.y * hr + gi[j]; hr = t; }
        }
        E[wave * 64 + lane] = (f32x2){hr, hi};
        __syncthreads();
        float sr = 0.f, si = 0.f;
        for (int i = 0; i < seg; ++i) { const f32x2 e = E[((wave & ~3) + i) * 64 + lane]; const float t = as.x * sr - as.y * si + e.x; si = as.x * si + as.y * sr + e.y; sr = t; }
        h16* H = (h16*)(P.ws + WS_UH) + ((size_t)g * ROWS_G + b * 512 + seg * 128) * UHK + 256 + lane;
        hr = sr; hi = si;
        for (int n = 0; n < 128; n += 8) {
            float gr[8], gi[8];
#pragma unroll
            for (int j = 0; j < 8; ++j) { gr[j] = Gp[(size_t)(n + j) * 128]; gi[j] = Gp[(size_t)(n + j) * 128 + 64]; }
#pragma unroll
            for (int j = 0; j < 8; ++j) { H[(size_t)(n + j) * UHK] = (h16)hr; H[(size_t)(n + j) * UHK + 64] = (h16)hi;
                const float t = a.x * hr - a.y * hi + gr[j]; hi = a.x * hi + a.y * hr + gi[j]; hr = t; }
        }
        __syncthreads();
    }
}

__device__ __forceinline__ int crow(int r, int hi) { return (r & 3) + 8 * (r >> 2) + 4 * hi; }
__device__ __forceinline__ void attn_phase(const Params& P, int layer, LAS unsigned char* lds) {
    const h16* q = (const h16*)(P.ws + WS_UH); const h16* k = (const h16*)(P.ws + WS_K); const h16* vt = (const h16*)(P.ws + WS_VT);
    const h16* gate = (const h16*)(P.ws + WS_GATE); h16* og = (h16*)(P.ws + WS_OG);
    const float* sinks = P.in[layer == 1 ? 16 : 33];
    int tid = threadIdx.x; asm volatile("" : "+v"(tid));
    const int lane = tid & 63, wave = __builtin_amdgcn_readfirstlane(tid >> 6), l31 = lane & 31, hi = lane >> 5;
    LAS h16* Ks = (LAS h16*)lds;
    LAS h16* Vs = (LAS h16*)(lds + 36864);
    LAS h16* Os = (LAS h16*)(lds + 70144) + wave * (32 * 72);
    const int G = gridDim.x;
    int unit = blockIdx.x;
    if (unit >= 1024) return;
    unsigned m0 = 0;
#pragma unroll
    for (int r = 0; r < 16; ++r) if (crow(r, hi) > l31) m0 |= 1u << r;
    const int grow = lane >> 3, gcol = (lane & 7) * 8;
    h8 kvr[8];
#define ATT_LOADKV(U) do { const int kvh_ = (U) & 1, blk_ = ((U) >> 1) & 63, b_ = (U) >> 7; \
        _Pragma("unroll") for (int c_ = 0; c_ < 4; ++c_) { const int id = tid + 512 * c_, key = id >> 3, part = id & 7; const int l = blk_ * 128 - 128 + key; \
            kvr[c_] = (h8)(h16)0.f; if (l >= 0) kvr[c_] = *(const h8*)(k + ((size_t)b_ * SEQ + l) * 128 + kvh_ * 64 + part * 8); } \
        _Pragma("unroll") for (int c_ = 0; c_ < 4; ++c_) { const int id = tid + 512 * c_, d = id >> 5, part = id & 31; const int l0 = blk_ * 128 - 128 + part * 8; \
            kvr[4 + c_] = (h8)(h16)0.f; if (l0 >= 0) kvr[4 + c_] = *(const h8*)(vt + ((size_t)((b_ * 2 + kvh_) * 64 + d)) * SEQ + l0); } } while (0)
#define ATT_STOREKV() do { \
        _Pragma("unroll") for (int c_ = 0; c_ < 4; ++c_) { const int id = tid + 512 * c_, key = id >> 3, part = id & 7; *(LAS h8*)(Ks + key * 72 + part * 8) = kvr[c_]; } \
        _Pragma("unroll") for (int c_ = 0; c_ < 4; ++c_) { const int id = tid + 512 * c_, d = id >> 5, part = id & 31; LAS h16* dst = Vs + d * 260 + part * 8; *(LAS h4*)dst = kvr[4 + c_].lo; *(LAS h4*)(dst + 4) = kvr[4 + c_].hi; } } while (0)
#define ATT_LOADQ(U, I) do { const int kvh_ = (U) & 1, blk_ = ((U) >> 1) & 63, b_ = (U) >> 7; const h16* qp = q + ((size_t)b_ * SEQ + blk_ * 128 + 32 * (I) + l31) * DM + (kvh_ * 8 + wave) * 64 + 8 * hi; \
        _Pragma("unroll") for (int ds = 0; ds < 4; ++ds) qf[ds] = *(const h8*)(qp + 16 * ds); } while (0)
    h8 qf[4];
    ATT_LOADKV(unit);
    ATT_LOADQ(unit, 0);
    ATT_STOREKV();
    __syncthreads();
    for (;;) {
        const int kvh = unit & 1, blk = (unit >> 1) & 63, b = unit >> 7, hq = kvh * 8 + wave;
        const float sink2 = sinks[hq] * LOG2E;
        const int nunit = unit + G; const bool has_next = nunit < 1024;
#pragma unroll
        for (int i = 0; i < 4; ++i) {
            const size_t tok0 = (size_t)b * SEQ + blk * 128 + 32 * i;
            if (i == 3 && has_next) ATT_LOADKV(nunit);
            f32x16 s[5];
#pragma unroll
            for (int t5 = 0; t5 < 5; ++t5) { f32x16 a16;
#pragma unroll
                for (int r = 0; r < 16; ++r) a16[r] = 0.f;
#pragma unroll
                for (int ds = 0; ds < 4; ++ds) { const h8 kf = *(const LAS h8*)(Ks + (32 * (i + t5) + l31) * 72 + 16 * ds + 8 * hi); a16 = __builtin_amdgcn_mfma_f32_32x32x16_f16(kf, qf[ds], a16, 0, 0, 0); }
                s[t5] = a16; }
            h8 gt[4];
#pragma unroll
            for (int j = 0; j < 4; ++j) gt[j] = *(const h8*)(gate + (tok0 + grow + 8 * j) * DM + hq * 64 + gcol);
#pragma unroll
            for (int r = 0; r < 16; ++r) { const bool in0 = (m0 >> r) & 1u; s[0][r] = in0 ? s[0][r] : -1e30f; s[4][r] = in0 ? -1e30f : s[4][r]; }
            if (blk == 0) {
#pragma unroll
                for (int t5 = 0; t5 < 4; ++t5) if (i + t5 < 4) {
#pragma unroll
                    for (int r = 0; r < 16; ++r) s[t5][r] = -1e30f; }
            }
            float mx = sink2;
#pragma unroll
            for (int t5 = 0; t5 < 5; ++t5)
#pragma unroll
                for (int r = 0; r < 16; ++r) mx = fmaxf(mx, s[t5][r]);
            mx = fmaxf(mx, __shfl_xor(mx, 32));
            float sum = 0.f;
#pragma unroll
            for (int t5 = 0; t5 < 5; ++t5)
#pragma unroll
                for (int r = 0; r < 16; ++r) { const float p = __builtin_amdgcn_exp2f(s[t5][r] - mx); s[t5][r] = p; sum += p; }
            sum += __shfl_xor(sum, 32);
            sum += __builtin_amdgcn_exp2f(sink2 - mx);
            const float inv = __builtin_amdgcn_rcpf(sum);
            f32x16 o0, o1;
#pragma unroll
            for (int r = 0; r < 16; ++r) { o0[r] = 0.f; o1[r] = 0.f; }
#pragma unroll
            for (int t5 = 0; t5 < 5; ++t5)
#pragma unroll
                for (int ss = 0; ss < 2; ++ss) { h8 pf;
#pragma unroll
                    for (int j = 0; j < 8; ++j) pf[j] = (h16)(s[t5][8 * ss + j] * inv);
                    const int kb = 32 * (i + t5) + 16 * ss + 4 * hi;
                    { const LAS h16* vp = Vs + l31 * 260 + kb; const h4 lo = *(const LAS h4*)vp, hi4 = *(const LAS h4*)(vp + 8);
                      const h8 vf = __builtin_shufflevector(lo, hi4, 0, 1, 2, 3, 4, 5, 6, 7); o0 = __builtin_amdgcn_mfma_f32_32x32x16_f16(pf, vf, o0, 0, 0, 0); }
                    { const LAS h16* vp = Vs + (32 + l31) * 260 + kb; const h4 lo = *(const LAS h4*)vp, hi4 = *(const LAS h4*)(vp + 8);
                      const h8 vf = __builtin_shufflevector(lo, hi4, 0, 1, 2, 3, 4, 5, 6, 7); o1 = __builtin_amdgcn_mfma_f32_32x32x16_f16(pf, vf, o1, 0, 0, 0); } }
            if (i < 3) ATT_LOADQ(unit, i + 1); else if (has_next) ATT_LOADQ(nunit, 0);
#pragma unroll
            for (int r = 0; r < 16; ++r) { LAS h16* op = Os + crow(r, hi) * 72 + l31; op[0] = (h16)o0[r]; op[32] = (h16)o1[r]; }
#pragma unroll
            for (int j = 0; j < 4; ++j) { const h8 ov = *(const LAS h8*)(Os + (grow + 8 * j) * 72 + gcol); h8 res;
#pragma unroll
                for (int e = 0; e < 8; ++e) { const float g = (float)gt[j][e]; res[e] = (h16)((float)ov[e] * g * sigmoidf_(g)); }
                *(h8*)(og + (tok0 + grow + 8 * j) * DM + hq * 64 + gcol) = res; }
        }
        if (!has_next) break;
        __syncthreads();
        ATT_STOREKV();
        __syncthreads();
        unit = nunit;
    }
#undef ATT_LOADKV
#undef ATT_STOREKV
#undef ATT_LOADQ
}

__device__ __forceinline__ void final_norm_phase(const Params& P) {
    int tid = threadIdx.x; asm volatile("" : "+v"(tid));
    const int lane = tid & 63, wave = tid >> 6; const int gw = blockIdx.x * 8 + wave, NGW = gridDim.x * 8;
    const float* ss = (const float*)(P.ws + WS_SUMSQ) + (size_t)4 * M_TOK; const f32x4* gn = (const f32x4*)P.in[35];
    f32x4 gv[4];
#pragma unroll
    for (int j = 0; j < 4; ++j) gv[j] = gn[64 * j + lane];
    for (int row = gw; row < M_TOK; row += NGW) { const float rs = rsqrtf(ss[row] * (1.0f / DM) + NORM_EPS); f32x4* xr = (f32x4*)(P.out + (size_t)row * DM) + lane;
#pragma unroll
        for (int j = 0; j < 4; ++j) { const f32x4 v = xr[64 * j]; xr[64 * j] = v * rs * gv[j]; } }
}

#ifndef PROBE_PHASE
#define PROBE_PHASE -1
#endif
#define PROBE_K 8
#define PB(id) do { if (PROBE_PHASE == (id) && layer < 2) pt0 = __builtin_amdgcn_s_memrealtime(); } while (0)
#define SYNC(id) do { grid.sync(); if (PROBE_PHASE == (id) && layer < 2 && blockIdx.x == 0) { const unsigned long long t1 = __builtin_amdgcn_s_memrealtime(); const unsigned long long dt = (t1 - pt0) * PROBE_K; \
    while (__builtin_amdgcn_s_memrealtime() - t1 < dt) __builtin_amdgcn_s_sleep(8); } } while (0)
constexpr int LDS_BYTES = 135168;
__global__ void __launch_bounds__(512) fwd_megakernel(Params P) {
    extern __shared__ __attribute__((aligned(16))) unsigned char lds_raw[];
    LAS unsigned char* lds = (LAS unsigned char*)lds_raw;
    cg::grid_group grid = cg::this_grid();
    const int G = gridDim.x, c = blockIdx.x;
    unsigned char* ws = P.ws;
    float* sumsq = (float*)(ws + WS_SUMSQ);
    h16* xh = (h16*)(ws + WS_XH); h16* UH = (h16*)(ws + WS_UH); float* Gp = (float*)(ws + WS_GP); h16* gate = (h16*)(ws + WS_GATE);
    h16* Zg = (h16*)(ws + WS_ZG); h16* og = (h16*)(ws + WS_OG);
    const AGeo plainA{2048u, 32u, 128};

#ifndef PH_MASK
#define PH_MASK 0xFFFF
#endif
    unsigned long long pt0 = 0;
    { const int layer = 0; PB(0); if (PH_MASK & 1) prep_phase(P, lds); SYNC(0); }

#pragma unroll 1
    for (int layer = 0; layer < 4; ++layer) {
        if ((layer & 1) == 0) {
            const int L = layer >> 1;
            const unsigned char* win = ws + (L ? W_IN2 : W_IN0); const unsigned char* wglu = ws + (L ? W_GLU2 : W_GLU0); const unsigned char* wout = ws + (L ? W_OUT2 : W_OUT0);
            const float* bglu = P.in[L ? 29 : 12];
            { PlainOrder S; S.init(M_TOK, 2048, G, c, xh, (size_t)256 * 2048, win, (size_t)256 * 2048);
              EpiG1Ssm E{sumsq + (size_t)layer * M_TOK, UH, gate};
              PB(1); if (PH_MASK & 2) gemm_phase(lds, plainA, 2048u, 16, S, E); }
            SYNC(1);
            { GroupOrder S{G, c, (const char*)UH, (const char*)(ws + WS_BT1) + (size_t)L * 64 * 256 * 256 * 2, (size_t)ROWS_G * UHK * 2, (size_t)256 * 256 * 2, (size_t)256 * UHK * 2};
              EpiS1 E{Gp};
              PB(2); if (PH_MASK & 4) gemm_phase(lds, AGeo{UHK * 2u, 32u, 128}, 512u, 4, S, E); }
            SYNC(2);
            PB(3); if (PH_MASK & 8) s2_phase(P, L, lds);
            SYNC(3);
            { GroupOrder S{G, c, (const char*)UH, (const char*)(ws + WS_BT3) + (size_t)L * 64 * 256 * 384 * 2, (size_t)ROWS_G * UHK * 2, (size_t)256 * 384 * 2, (size_t)256 * UHK * 2};
              EpiS3 E{(const float*)(ws + WS_STEP) + L * 64, Zg};
              PB(4); if (PH_MASK & 16) gemm_phase(lds, AGeo{UHK * 2u, 32u, 128}, 768u, 6, S, E); }
            SYNC(4);
            { PlainOrder S; S.init(M_TOK, 1024, G, c, Zg, (size_t)256 * 32, wglu, (size_t)256 * 2048);
              EpiGlu E{Zg, gate, bglu, og};
              PB(5); if (PH_MASK & 32) gemm_phase(lds, AGeo{32u, (unsigned)(M_TOK * 32), (size_t)4 * M_TOK * 32}, 2048u, 16, S, E); }
            SYNC(5);
            { PlainOrder S; S.init(M_TOK, 1024, G, c, og, (size_t)256 * 2048, wout, (size_t)256 * 2048);
              EpiOut<false> E{xh, P.out, sumsq + (size_t)(layer + 1) * M_TOK};
              PB(6); if (PH_MASK & 64) gemm_phase(lds, plainA, 2048u, 16, S, E); }
            SYNC(6);
        } else {
            const unsigned char* win = ws + (layer == 1 ? W_IN1 : W_IN3); const unsigned char* wout = ws + (layer == 1 ? W_OUT1 : W_OUT3);
            { PlainOrder S; S.init(M_TOK, 2304, G, c, xh, (size_t)256 * 2048, win, (size_t)256 * 2048);
              EpiG1Att E{sumsq + (size_t)layer * M_TOK, (const f32x2*)(ws + WS_ROPE), (h16*)(ws + WS_UH), (h16*)(ws + WS_K), (h16*)(ws + WS_VT), gate};
              PB(7); if (PH_MASK & 128) gemm_phase(lds, plainA, 2048u, 16, S, E); }
            SYNC(7);
            PB(8); if (PH_MASK & 256) attn_phase(P, layer, lds);
            SYNC(8);
            { PlainOrder S; S.init(M_TOK, 1024, G, c, og, (size_t)256 * 2048, wout, (size_t)256 * 2048);
              if (layer == 1) { EpiOut<false> E{xh, P.out, sumsq + (size_t)(layer + 1) * M_TOK};
                PB(9); if (PH_MASK & 512) gemm_phase(lds, plainA, 2048u, 16, S, E); }
              else { EpiOut<true> E{xh, P.out, sumsq + (size_t)(layer + 1) * M_TOK};
                if (PH_MASK & 512) gemm_phase(lds, plainA, 2048u, 16, S, E); } }
            SYNC(9);
        }
    }
    { const int layer = 0; PB(10); if (PH_MASK & 1024) final_norm_phase(P);
      if (PROBE_PHASE == 10 && blockIdx.x == 0) { const unsigned long long t1 = __builtin_amdgcn_s_memrealtime(); const unsigned long long dt = (t1 - pt0) * PROBE_K; while (__builtin_amdgcn_s_memrealtime() - t1 < dt) __builtin_amdgcn_s_sleep(8); } }
}

extern "C" void kernel_launch(void* const* d_in, const int* in_sizes, int n_in, void* d_out, int out_size, void* d_ws, size_t ws_size, hipStream_t stream) {
    static int grid_blocks = 0;
    if (grid_blocks == 0) {
        if (n_in != 36 || ws_size < WS_END) { fprintf(stderr, "kernel_launch: unexpected n_in %d / ws %zu\n", n_in, ws_size); grid_blocks = -1; return; }
        int dev = 0, cus = 0, per_cu = 0;
        hipGetDevice(&dev);
        hipDeviceGetAttribute(&cus, hipDeviceAttributeMultiprocessorCount, dev);
        hipFuncSetAttribute((const void*)fwd_megakernel, hipFuncAttributeMaxDynamicSharedMemorySize, LDS_BYTES);
        hipOccupancyMaxActiveBlocksPerMultiprocessor(&per_cu, (const void*)fwd_megakernel, 512, LDS_BYTES);
        if (per_cu < 1) per_cu = 1;
        grid_blocks = cus * per_cu;
        (void)hipGetLastError();
    }
    if (grid_blocks < 0) return;
    Params p{};
    for (int i = 0; i < 36; ++i) p.in[i] = (const float*)d_in[i];
    p.out = (float*)d_out; p.ws = (unsigned char*)d_ws;
    void* args[] = {&p};
    hipError_t e = hipLaunchCooperativeKernel((const void*)fwd_megakernel, dim3(grid_blocks), dim3(512), args, LDS_BYTES, stream);
    if (e != hipSuccess) fprintf(stderr, "cooperative launch failed: %s (grid %d)\n", hipGetErrorString(e), grid_blocks);
}
```

```cpp
#include <hip/hip_runtime.h>
#include <hip/hip_cooperative_groups.h>
#include <cstdint>
#include <cstdio>
namespace cg = cooperative_groups;

#define LAS __attribute__((address_space(3)))
typedef _Float16 h16;
typedef _Float16 h8 __attribute__((ext_vector_type(8)));
typedef _Float16 h4 __attribute__((ext_vector_type(4)));
typedef float f32x4 __attribute__((ext_vector_type(4)));
typedef float f32x2 __attribute__((ext_vector_type(2)));
typedef float f32x16 __attribute__((ext_vector_type(16)));

__device__ __forceinline__ int get_tid(int wave_s) { int t = wave_s * 64 + (int)__builtin_amdgcn_mbcnt_hi(~0u, __builtin_amdgcn_mbcnt_lo(~0u, 0u)); asm volatile("" : "+v"(t)); return t; }

constexpr int M_TOK = 65536, DM = 1024, SEQ = 8192;
constexpr int ROWS_G = 4096;
constexpr int UHK = 384;
constexpr float NORM_EPS = 1e-5f;
constexpr float LOG2E = 1.4426950408889634f;

constexpr size_t MiB = 1u << 20;
constexpr size_t WS_SUMSQ = 0;
constexpr size_t WS_ROPE  = 2 * MiB;
constexpr size_t WS_A16   = 4 * MiB;
constexpr size_t WS_ASEG  = 4 * MiB + 65536;
constexpr size_t WS_STEP  = 4 * MiB + 131072;
constexpr size_t WS_BAR   = 5 * MiB;
constexpr size_t WS_CNT   = 4 * MiB + 196608;
constexpr size_t WS_W     = 8 * MiB;
constexpr size_t W_IN0 = WS_W, W_GLU0 = W_IN0 + 4 * MiB, W_OUT0 = W_GLU0 + 2 * MiB;
constexpr size_t W_IN1 = W_OUT0 + 2 * MiB, W_OUT1 = W_IN1 + 5 * MiB;
constexpr size_t W_IN2 = W_OUT1 + 2 * MiB, W_GLU2 = W_IN2 + 4 * MiB, W_OUT2 = W_GLU2 + 2 * MiB;
constexpr size_t W_IN3 = W_OUT2 + 2 * MiB, W_OUT3 = W_IN3 + 5 * MiB;
constexpr size_t WS_BT1 = 40 * MiB;
constexpr size_t WS_BT3 = 56 * MiB;
constexpr size_t WS_XH  = 80 * MiB;
constexpr size_t WS_UH  = 208 * MiB;
constexpr size_t WS_GP  = 400 * MiB;
constexpr size_t WS_K   = WS_GP, WS_VT = WS_GP + 32 * MiB;
constexpr size_t WS_GATE = 528 * MiB;
constexpr size_t WS_ZG  = 656 * MiB;
constexpr size_t WS_OG  = 784 * MiB;
constexpr size_t WS_END = 912 * MiB;

#define XCD_BAR_WORDS 3456
struct Params { const float* in[36]; float* out; unsigned char* ws; };

constexpr int BM = 256, BK = 64, HALF = 128, HTB = HALF * BK * 2, STAGE_BYTES = 8 * HTB, NXCD = 8, WGM = 8;
__device__ __forceinline__ int lds_byte(int r, int c) { const int st = (r >> 4) * 2 + (c >> 5), rr = r & 15, cc = c & 31, ob = rr * 64 + cc * 2; return st * 1024 + (ob ^ (((ob >> 9) & 1) << 5)); }
__device__ __forceinline__ void stage_rc(int b, int& R, int& C) { const int st = b / 1024, sb = b % 1024, swz = sb ^ (((sb >> 9) & 1) << 5); R = (st >> 1) * 16 + swz / 64; C = (st & 1) * 32 + (swz % 64) / 2; }
__device__ __forceinline__ int perm32(int rho) { const int n = rho >> 4, i = rho & 15; return 8 * (i >> 2) + 4 * n + (i & 3); }

struct GUnit { const char* a; const char* b; int pm, pn, g; };
struct AGeo { unsigned lda, slab; size_t kstep; };

struct PlainOrder {
    int nM, nN, nwg, G, c; const char* A; const char* B; size_t ta, tb;
    __device__ __forceinline__ void init(int M, int N, int G_, int c_, const void* A_, size_t ta_, const void* B_, size_t tb_) { nM = M / BM; nN = N / BM; nwg = nM * nN; G = G_; c = c_; A = (const char*)A_; B = (const char*)B_; ta = ta_; tb = tb_; }
    __device__ __forceinline__ bool next(int i, GUnit& u) const {
        const long L = (long)i * G + c; if (L >= nwg) return false;
        int wgid = (int)L; { const int q = nwg / NXCD, r = nwg % NXCD, xcd = wgid % NXCD, off = wgid / NXCD; wgid = (xcd < r ? xcd * (q + 1) : r * (q + 1) + (xcd - r) * q) + off; }
        const int nig = WGM * nN, gid = wgid / nig, fm = gid * WGM, gsz = (nM - fm) < WGM ? (nM - fm) : WGM;
        u.pm = fm + ((wgid % nig) % gsz); u.pn = (wgid % nig) / gsz; u.g = 0;
        u.a = A + (size_t)u.pm * ta; u.b = B + (size_t)u.pn * tb; return true;
    }
};
struct GroupOrder {
    int G, c; const char* A; const char* B; size_t gsa, gsb, ta;
    __device__ __forceinline__ bool next(int i, GUnit& u) const {
        const long L = (long)i * G + c; if (L >= 1024) return false;
        int g, pm;
        if (G == 256) { const int xcd = c & 7, j = c >> 3; g = i * 16 + xcd * 2 + (j >> 4); pm = j & 15; }
        else { g = (int)(L >> 4); pm = (int)(L & 15); }
        u.g = g; u.pm = pm; u.pn = 0; u.a = A + (size_t)g * gsa + (size_t)pm * ta; u.b = B + (size_t)g * gsb; return true;
    }
};

template <class Epi, class Sched>
__device__ __forceinline__ void gemm_phase(LAS unsigned char* lds, const int wave_s, const AGeo ga, const unsigned ldb, const int nt, const Sched& S, const Epi& E) {
    const int tid = get_tid(wave_s);
    const int wid = __builtin_amdgcn_readfirstlane(tid >> 6), lane = tid & 63, wr = wid >> 2, wc = wid & 3, fr = lane & 15, fq = lane >> 4;
    unsigned voffA[2], voffB[2];
#pragma unroll
    for (int i = 0; i < 2; ++i) { int R, C; stage_rc(tid * 16 + i * 8192, R, C); const int Rb = (R & ~31) + perm32(R & 31);
        voffA[i] = (unsigned)R * ga.lda + (unsigned)(C >> 4) * ga.slab + (unsigned)(C & 15) * 2u; voffB[i] = (unsigned)Rb * ldb + (unsigned)C * 2u; }
    const size_t kA = ga.kstep, kB = 128;
    const size_t hA = (size_t)HALF * ga.lda, hB = (size_t)HALF * ldb;
    const unsigned ldsw = (unsigned)wid * 1024u;
    const int aoff = lds_byte(wr * 64 + fr, fq * 8), boff = lds_byte(wc * 32 + fr, fq * 8);
#define PG8_SA(b, h) (((b) * 2 + (h)) * HTB)
#define PG8_SB(b, h) ((4 + (b) * 2 + (h)) * HTB)
#define PG8_STAGE(bufoff, gbase, voff) do { _Pragma("unroll") for (int _i = 0; _i < 2; ++_i) \
        __builtin_amdgcn_global_load_lds((const unsigned*)((const char*)(gbase) + (voff)[_i]), (LAS unsigned*)(lds + (bufoff) + ldsw + _i * 8192), 16, 0, 0); } while (0)
#define PG8_LDA(dst, b, h) do { _Pragma("unroll") for (int m = 0; m < 4; ++m) _Pragma("unroll") for (int k = 0; k < 2; ++k) dst[m][k] = *(const LAS h8*)(lds + PG8_SA(b, h) + aoff + m * 2048 + k * 1024); } while (0)
#define PG8_LDB(dst, b, h) do { _Pragma("unroll") for (int n = 0; n < 2; ++n) _Pragma("unroll") for (int k = 0; k < 2; ++k) dst[n][k] = *(const LAS h8*)(lds + PG8_SB(b, h) + boff + n * 2048 + k * 1024); } while (0)
#define PG8_MMA(ai, bj, At, Bt) do { __builtin_amdgcn_s_setprio(1); _Pragma("unroll") for (int m = 0; m < 4; ++m) _Pragma("unroll") for (int n = 0; n < 2; ++n) _Pragma("unroll") for (int k = 0; k < 2; ++k) \
        acc[ai][bj][m][n] = __builtin_amdgcn_mfma_f32_16x16x32_f16(Bt[n][k], At[m][k], acc[ai][bj][m][n], 0, 0, 0); __builtin_amdgcn_s_setprio(0); } while (0)
#define PG8_WAIT_V(n) asm volatile("s_waitcnt vmcnt(" #n ")" ::: "memory")
#define PG8_WAIT_L(n) asm volatile("s_waitcnt lgkmcnt(" #n ")" ::: "memory")
#define PG8_BAR __builtin_amdgcn_s_barrier()
#define PG8_SCHED __builtin_amdgcn_sched_barrier(0)
    GUnit cur, nxt; int ui = 0;
    if (!S.next(0, cur)) return;
    f32x4 acc[2][2][4][2];
#pragma unroll
    for (int a = 0; a < 2; ++a)
#pragma unroll
        for (int b = 0; b < 2; ++b)
#pragma unroll
            for (int m = 0; m < 4; ++m)
#pragma unroll
                for (int n = 0; n < 2; ++n) acc[a][b][m][n] = (f32x4){0.f, 0.f, 0.f, 0.f};
    h8 At[4][2], B0[2][2], B1[2][2];
    const char* cA = cur.a; const char* cB = cur.b;
    PG8_STAGE(PG8_SB(0, 0), cB, voffB); PG8_STAGE(PG8_SB(0, 1), cB + hB, voffB); PG8_STAGE(PG8_SA(0, 0), cA, voffA); PG8_STAGE(PG8_SA(0, 1), cA + hA, voffA);
    if (wr == 1) PG8_BAR;
    PG8_WAIT_V(2); PG8_BAR;
    PG8_STAGE(PG8_SB(1, 0), cB + kB, voffB); PG8_STAGE(PG8_SA(1, 0), cA + kA, voffA); PG8_STAGE(PG8_SB(1, 1), cB + hB + kB, voffB);
    PG8_WAIT_V(6); PG8_BAR;
    for (;;) {
        const bool has_next = S.next(ui + 1, nxt);
        const char* nA = has_next ? nxt.a : cA; const char* nB = has_next ? nxt.b : cB;
#pragma unroll 1
        for (int t = 0; t < nt; t += 2) {
            const bool last = (t == nt - 2);
            const char* a1 = cA + (size_t)(t + 1) * kA;
            const char* a2 = last ? nA : cA + (size_t)(t + 2) * kA; const char* b2 = last ? nB : cB + (size_t)(t + 2) * kB;
            const char* a3 = a2 + kA; const char* b3 = b2 + kB;
            PG8_LDB(B0, 0, 0); PG8_LDB(B1, 0, 1); PG8_SCHED; PG8_LDA(At, 0, 0); PG8_STAGE(PG8_SA(1, 1), a1 + hA, voffA);
            PG8_WAIT_V(8); PG8_WAIT_L(0); PG8_BAR; PG8_MMA(0, 0, At, B0); PG8_MMA(0, 1, At, B1); PG8_BAR; PG8_SCHED;
            PG8_LDA(At, 0, 1); PG8_STAGE(PG8_SB(0, 0), b2, voffB); PG8_STAGE(PG8_SB(0, 1), b2 + hB, voffB); PG8_STAGE(PG8_SA(0, 0), a2, voffA);
            PG8_WAIT_V(8); PG8_WAIT_L(0); PG8_BAR; PG8_MMA(1, 0, At, B0); PG8_MMA(1, 1, At, B1); PG8_BAR; PG8_SCHED;
            PG8_LDB(B0, 1, 0); PG8_LDB(B1, 1, 1); PG8_SCHED; PG8_LDA(At, 1, 0); PG8_STAGE(PG8_SA(0, 1), a2 + hA, voffA);
            PG8_WAIT_V(8); PG8_WAIT_L(0); PG8_BAR; PG8_MMA(0, 0, At, B0); PG8_MMA(0, 1, At, B1); PG8_BAR; PG8_SCHED;
            PG8_LDA(At, 1, 1); PG8_STAGE(PG8_SB(1, 0), b3, voffB); PG8_STAGE(PG8_SB(1, 1), b3 + hB, voffB); PG8_STAGE(PG8_SA(1, 0), a3, voffA);
            PG8_WAIT_V(8); PG8_WAIT_L(0); PG8_BAR; PG8_MMA(1, 0, At, B0); PG8_MMA(1, 1, At, B1); PG8_BAR; PG8_SCHED;
        }
        if (wr == 0) PG8_BAR;
        E(acc, cur, wr, wc, fr, fq);
        if (!has_next) break;
#pragma unroll
        for (int a = 0; a < 2; ++a)
#pragma unroll
            for (int b = 0; b < 2; ++b)
#pragma unroll
                for (int m = 0; m < 4; ++m)
#pragma unroll
                    for (int n = 0; n < 2; ++n) acc[a][b][m][n] = (f32x4){0.f, 0.f, 0.f, 0.f};
        cur = nxt; cA = nA; cB = nB; ++ui;
        if (wr == 1) PG8_BAR;
    }
    PG8_WAIT_V(0);
    PG8_BAR;
#undef PG8_SA
#undef PG8_SB
#undef PG8_STAGE
#undef PG8_LDA
#undef PG8_LDB
#undef PG8_MMA
#undef PG8_WAIT_V
#undef PG8_WAIT_L
#undef PG8_BAR
#undef PG8_SCHED
}

__device__ __forceinline__ h8 pack8(f32x4 a, f32x4 b) { h8 r; r[0] = (h16)a[0]; r[1] = (h16)a[1]; r[2] = (h16)a[2]; r[3] = (h16)a[3]; r[4] = (h16)b[0]; r[5] = (h16)b[1]; r[6] = (h16)b[2]; r[7] = (h16)b[3]; return r; }
__device__ __forceinline__ float sigmoidf_(float x) { return __builtin_amdgcn_rcpf(1.0f + __expf(-x)); }

struct EpiG1Ssm {
    const float* sumsq; h16* UH; h16* gate;
    __device__ __forceinline__ void operator()(const f32x4 (&acc)[2][2][4][2], const GUnit& u, int wr, int wc, int fr, int fq) const {
#pragma unroll
        for (int ai = 0; ai < 2; ++ai)
#pragma unroll
            for (int m = 0; m < 4; ++m) {
                const int row = u.pm * BM + ai * HALF + wr * 64 + m * 16 + fr;
                const float rs = rsqrtf(sumsq[row] * (1.0f / DM) + NORM_EPS);
#pragma unroll
                for (int bj = 0; bj < 2; ++bj) {
                    const int ch0 = u.pn * BM + bj * HALF + wc * 32 + 8 * fq;
                    const h8 v = pack8(acc[ai][bj][m][0] * rs, acc[ai][bj][m][1] * rs);
                    if (ch0 < 1024) { const int g = ch0 >> 4, c0 = ch0 & 15;
                        *(h8*)(UH + ((size_t)g * ROWS_G + (row >> 4)) * UHK + (row & 15) * 16 + c0) = v; }
                    else *(h8*)(gate + (size_t)row * DM + (ch0 - 1024)) = v;
                }
            }
    }
};
struct EpiS1 {
    float* Gp;
    __device__ __forceinline__ void operator()(const f32x4 (&acc)[2][2][4][2], const GUnit& u, int wr, int wc, int fr, int fq) const {
#pragma unroll
        for (int ai = 0; ai < 2; ++ai)
#pragma unroll
            for (int m = 0; m < 4; ++m) {
                const int row = u.pm * BM + ai * HALF + wr * 64 + m * 16 + fr;
                float* p = Gp + ((size_t)u.g * ROWS_G + row) * 128 + wc * 32 + 8 * fq;
                *(f32x4*)p = acc[ai][0][m][0]; *(f32x4*)(p + 4) = acc[ai][0][m][1];
            }
    }
};
struct EpiS3 {
    const float* stepv; h16* Zg;
    static __device__ __forceinline__ float gelu1(float a) { return a * __builtin_amdgcn_rcpf(1.0f + __expf(-1.5957691216f * (a + 0.044715f * a * a * a))); }
    __device__ __forceinline__ void operator()(const f32x4 (&acc)[2][2][4][2], const GUnit& u, int wr, int wc, int fr, int fq) const {
        const float st = stepv[u.g];
        h16* base = Zg + (size_t)u.g * M_TOK * 16 + (size_t)(u.pm * BM + wr * 64 + fr) * 256 + wc * 32 + 8 * fq;
#pragma unroll
        for (int ai = 0; ai < 2; ++ai)
#pragma unroll
            for (int m = 0; m < 4; ++m) {
#pragma unroll
                for (int bj = 0; bj < 2; ++bj) {
                    const f32x4 y0 = acc[ai][bj][m][0] * st, y1 = acc[ai][bj][m][1] * st;
                    h8 o;
#pragma unroll
                    for (int j = 0; j < 4; ++j) { o[j] = (h16)gelu1(y0[j]); o[4 + j] = (h16)gelu1(y1[j]); }
                    *(h8*)(base + (size_t)(ai * HALF + m * 16) * 256 + bj * HALF) = o;
                    __builtin_amdgcn_sched_barrier(0);
                }
            }
    }
};
struct EpiGlu {
    const h16* Zg; const h16* gate; const float* bias; h16* og;
    __device__ __forceinline__ void operator()(const f32x4 (&acc)[2][2][4][2], const GUnit& u, int wr, int wc, int fr, int fq) const {
        const int rowb = u.pm * BM + wr * 64 + fr, nb = u.pn * BM + wc * 32 + 8 * fq;
        h8 zb[3], gb[3];
#define GLU_ISSUE(gi) do { const int bj_ = (gi) >> 3, ai_ = ((gi) >> 2) & 1, m_ = (gi) & 3, n0_ = nb + bj_ * HALF, row_ = rowb + ai_ * HALF + m_ * 16; \
            zb[(gi) % 3] = *(const h8*)(Zg + ((size_t)(n0_ >> 4) * M_TOK + row_) * 16 + (n0_ & 15)); gb[(gi) % 3] = *(const h8*)(gate + (size_t)row_ * DM + n0_); } while (0)
        GLU_ISSUE(0); GLU_ISSUE(1);
        f32x4 b0, b1;
#pragma unroll
        for (int gi = 0; gi < 16; ++gi) {
            if (gi + 2 < 16) GLU_ISSUE(gi + 2);
            const int bj = gi >> 3, ai = (gi >> 2) & 1, m = gi & 3, n0 = nb + bj * HALF, row = rowb + ai * HALF + m * 16;
            if ((gi & 7) == 0) { b0 = *(const f32x4*)(bias + n0); b1 = *(const f32x4*)(bias + n0 + 4); }
            const h8 z = zb[gi % 3], gt = gb[gi % 3];
            const f32x4 a0 = acc[ai][bj][m][0] + b0, a1 = acc[ai][bj][m][1] + b1;
            h8 o;
#pragma unroll
            for (int j = 0; j < 4; ++j) {
                const float g0 = (float)gt[j], g1 = (float)gt[4 + j];
                o[j] = (h16)((float)z[j] * g0 * __builtin_amdgcn_rcpf((1.0f + __expf(-a0[j])) * (1.0f + __expf(-g0))));
                o[4 + j] = (h16)((float)z[4 + j] * g1 * __builtin_amdgcn_rcpf((1.0f + __expf(-a1[j])) * (1.0f + __expf(-g1))));
            }
            *(h8*)(og + (size_t)row * DM + n0) = o;
            __builtin_amdgcn_sched_barrier(0);
        }
#undef GLU_ISSUE
    }
};
struct EpiOut {
    h16* xh; float* sumsq;
    __device__ __forceinline__ void operator()(const f32x4 (&acc)[2][2][4][2], const GUnit& u, int wr, int wc, int fr, int fq) const {
        const int rowb = u.pm * BM + wr * 64 + fr, nb = u.pn * BM + wc * 32 + 8 * fq;
        h8 xb[3][2];
#define OUT_ISSUE(gi) do { _Pragma("unroll") for (int bj = 0; bj < 2; ++bj) xb[(gi) % 3][bj] = *(const h8*)(xh + (size_t)(rowb + ((gi) >> 2) * HALF + ((gi) & 3) * 16) * DM + nb + bj * HALF); } while (0)
        OUT_ISSUE(0); OUT_ISSUE(1);
#pragma unroll
        for (int gi = 0; gi < 8; ++gi) {
            if (gi + 2 < 8) OUT_ISSUE(gi + 2);
            const int ai = gi >> 2, m = gi & 3, row = rowb + ai * HALF + m * 16;
            float ss = 0.f;
#pragma unroll
            for (int bj = 0; bj < 2; ++bj) {
                const h8 xo = xb[gi % 3][bj];
                f32x4 v0, v1;
#pragma unroll
                for (int j = 0; j < 4; ++j) { v0[j] = (float)xo[j] + acc[ai][bj][m][0][j]; v1[j] = (float)xo[4 + j] + acc[ai][bj][m][1][j]; }
                const h8 xn = pack8(v0, v1); *(h8*)(xh + (size_t)row * DM + nb + bj * HALF) = xn;
#pragma unroll
                for (int j = 0; j < 4; ++j) { const float a = (float)xn[j], b = (float)xn[4 + j]; ss += a * a + b * b; }
            }
            ss += __shfl_xor(ss, 16); ss += __shfl_xor(ss, 32);
            if (fq == 0) atomicAdd(sumsq + row, ss);
            __builtin_amdgcn_sched_barrier(0);
        }
#undef OUT_ISSUE
    }
};
struct EpiOutFinal {
    const h16* xh; float* out; float* sumsq; unsigned* cnt; const float* gfin;
    __device__ __forceinline__ void operator()(f32x4 (&acc)[2][2][4][2], const GUnit& u, int wr, int wc, int fr, int fq) const {
        const int rowb = u.pm * BM + wr * 64 + fr, nb = u.pn * BM + wc * 32 + 8 * fq;
        float dummy = 0.f;
#pragma unroll
        for (int ai = 0; ai < 2; ++ai)
#pragma unroll
            for (int m = 0; m < 4; ++m) {
                const int row = rowb + ai * HALF + m * 16;
                float ss = 0.f;
#pragma unroll
                for (int bj = 0; bj < 2; ++bj) {
                    const h8 xo = *(const h8*)(xh + (size_t)row * DM + nb + bj * HALF);
#pragma unroll
                    for (int j = 0; j < 4; ++j) { const float a = (float)xo[j] + acc[ai][bj][m][0][j], b = (float)xo[4 + j] + acc[ai][bj][m][1][j]; acc[ai][bj][m][0][j] = a; acc[ai][bj][m][1][j] = b; ss += a * a + b * b; }
                }
                ss += __shfl_xor(ss, 16); ss += __shfl_xor(ss, 32);
                if (fq == 0) dummy += atomicAdd(sumsq + row, ss);
            }
        asm volatile("s_waitcnt vmcnt(0)" :: "v"(dummy) : "memory");
        if (fr == 0 && fq == 0) __hip_atomic_fetch_add(cnt + u.pm, 1u, __ATOMIC_RELAXED, __HIP_MEMORY_SCOPE_AGENT);
        if (wr == 0 && wc == 0) { while (__hip_atomic_load(cnt + u.pm, __ATOMIC_RELAXED, __HIP_MEMORY_SCOPE_AGENT) < 32u) __builtin_amdgcn_s_sleep(1); }
        __builtin_amdgcn_s_barrier();
        f32x4 g[2][2];
#pragma unroll
        for (int bj = 0; bj < 2; ++bj) { g[bj][0] = *(const f32x4*)(gfin + nb + bj * HALF); g[bj][1] = *(const f32x4*)(gfin + nb + bj * HALF + 4); }
#pragma unroll
        for (int ai = 0; ai < 2; ++ai)
#pragma unroll
            for (int m = 0; m < 4; ++m) {
                const int row = rowb + ai * HALF + m * 16;
                const float rs = rsqrtf(__hip_atomic_load(sumsq + row, __ATOMIC_RELAXED, __HIP_MEMORY_SCOPE_AGENT) * (1.0f / DM) + NORM_EPS);
#pragma unroll
                for (int bj = 0; bj < 2; ++bj) { float* o = out + (size_t)row * DM + nb + bj * HALF;
                    *(f32x4*)o = acc[ai][bj][m][0] * rs * g[bj][0]; *(f32x4*)(o + 4) = acc[ai][bj][m][1] * rs * g[bj][1]; }
            }
    }
};
struct EpiOutLast {
    const h16* xh; float* out; float* sumsq;
    __device__ __forceinline__ void operator()(const f32x4 (&acc)[2][2][4][2], const GUnit& u, int wr, int wc, int fr, int fq) const {
        const int rowb = u.pm * BM + wr * 64 + fr, nb = u.pn * BM + wc * 32 + 8 * fq;
#pragma unroll
        for (int ai = 0; ai < 2; ++ai)
#pragma unroll
            for (int m = 0; m < 4; ++m) {
                const int row = rowb + ai * HALF + m * 16;
                float ss = 0.f;
#pragma unroll
                for (int bj = 0; bj < 2; ++bj) {
                    const size_t off = (size_t)row * DM + nb + bj * HALF;
                    const h8 xo = *(const h8*)(xh + off); f32x4 v0, v1;
#pragma unroll
                    for (int j = 0; j < 4; ++j) { v0[j] = (float)xo[j] + acc[ai][bj][m][0][j]; v1[j] = (float)xo[4 + j] + acc[ai][bj][m][1][j]; ss += v0[j] * v0[j] + v1[j] * v1[j]; }
                    *(f32x4*)(out + off) = v0; *(f32x4*)(out + off + 4) = v1;
                }
                ss += __shfl_xor(ss, 16); ss += __shfl_xor(ss, 32);
                if (fq == 0) atomicAdd(sumsq + row, ss);
            }
    }
};
struct EpiG1Att {
    const float* sumsq; const f32x2* rope; h16* q; h16* k; h16* vt; h16* gate;
    __device__ __forceinline__ void operator()(const f32x4 (&acc)[2][2][4][2], const GUnit& u, int wr, int wc, int fr, int fq) const {
#pragma unroll
        for (int ai = 0; ai < 2; ++ai)
#pragma unroll
            for (int m = 0; m < 4; ++m) {
                const int row = u.pm * BM + ai * HALF + wr * 64 + m * 16 + fr;
                const int l = row & (SEQ - 1);
                const float rs = rsqrtf(sumsq[row] * (1.0f / DM) + NORM_EPS);
#pragma unroll
                for (int bj = 0; bj < 2; ++bj) {
                    const int ct = bj * HALF + wc * 32 + 8 * fq;
                    f32x4 v0 = acc[ai][bj][m][0] * rs, v1 = acc[ai][bj][m][1] * rs;
                    if (u.pn < 4 || (u.pn == 4 && bj == 0)) {
                        const int i0 = (ct & 63) >> 1;
                        const f32x2 cs0 = rope[l * 32 + i0], cs1 = rope[l * 32 + i0 + 1], cs2 = rope[l * 32 + i0 + 2], cs3 = rope[l * 32 + i0 + 3];
                        const float sc = (u.pn < 4) ? 0.125f * LOG2E : 1.0f;
                        f32x4 r0, r1;
                        r0[0] = (v0[0] * cs0.x - v0[1] * cs0.y) * sc; r0[1] = (v0[1] * cs0.x + v0[0] * cs0.y) * sc;
                        r0[2] = (v0[2] * cs1.x - v0[3] * cs1.y) * sc; r0[3] = (v0[3] * cs1.x + v0[2] * cs1.y) * sc;
                        r1[0] = (v1[0] * cs2.x - v1[1] * cs2.y) * sc; r1[1] = (v1[1] * cs2.x + v1[0] * cs2.y) * sc;
                        r1[2] = (v1[2] * cs3.x - v1[3] * cs3.y) * sc; r1[3] = (v1[3] * cs3.x + v1[2] * cs3.y) * sc;
                        const h8 o = pack8(r0, r1);
                        if (u.pn < 4) *(h8*)(q + (size_t)row * DM + u.pn * BM + ct) = o;
                        else *(h8*)(k + (size_t)row * 128 + ct) = o;
                    } else if (u.pn == 4) {
                        const int vc = ct - 128, kvh = vc >> 6, d0 = vc & 63, b = row >> 13;
                        h16* dst = vt + ((size_t)((b * 2 + kvh) * 64 + d0)) * SEQ + l;
#pragma unroll
                        for (int j = 0; j < 4; ++j) { dst[(size_t)j * SEQ] = (h16)v0[j]; dst[(size_t)(4 + j) * SEQ] = (h16)v1[j]; }
                    } else {
                        *(h8*)(gate + (size_t)row * DM + (u.pn - 5) * BM + ct) = pack8(v0, v1);
                    }
                }
            }
    }
};

__device__ __forceinline__ float wave_sum(float v) {
#pragma unroll
    for (int o = 1; o < 64; o <<= 1) v += __shfl_xor(v, o);
    return v;
}
template <int MODE>
__device__ __forceinline__ void transpose_item(const float* W, int K, int N, h16* WT, const float* gsc, LAS float* scr, int item, int lane) {
    const int nblk = N / 32, kb = item / nblk, nb = item % nblk, k0 = 64 * kb, n0 = 32 * nb;
    const int nd = n0 + (lane & 31); int src = nd;
    if (MODE == 1 && nd < 1152) { const int j = nd & 63; src = (nd & ~63) + (j >> 1) + 32 * (j & 1); }
#pragma unroll 8
    for (int i = 0; i < 32; ++i) { const int kk = 2 * i + (lane >> 5); float v = W[(size_t)(k0 + kk) * N + src]; if (gsc) v *= gsc[k0 + kk]; scr[kk * 33 + (lane & 31)] = v; }
    asm volatile("s_waitcnt lgkmcnt(0)" ::: "memory");
    const int c = lane & 7;
#pragma unroll
    for (int j = 0; j < 4; ++j) { const int n = (lane >> 3) + 8 * j; const LAS float* s = scr + (8 * c) * 33 + n;
        h8 o; o[0] = (h16)s[0 * 33]; o[1] = (h16)s[1 * 33]; o[2] = (h16)s[2 * 33]; o[3] = (h16)s[3 * 33]; o[4] = (h16)s[4 * 33]; o[5] = (h16)s[5 * 33]; o[6] = (h16)s[6 * 33]; o[7] = (h16)s[7 * 33];
        *(h8*)(WT + (size_t)(n0 + n) * K + k0 + 8 * c) = o; }
    asm volatile("s_waitcnt lgkmcnt(0)" ::: "memory");
}

__device__ __forceinline__ void ssm_prep_item(const Params& P, int L, int g, LAS unsigned char* lds, const int tid) {
    const int base = (L == 0) ? 1 : 18;
    const float* a_re = P.in[base + 2] + g * 64; const float* a_im = P.in[base + 3] + g * 64; const float* log_step = P.in[base + 4];
    const float* b_re = P.in[base + 5] + g * 1024; const float* b_im = P.in[base + 6] + g * 1024;
    const float* c_re = P.in[base + 7] + g * 1024; const float* c_im = P.in[base + 8] + g * 1024;
    const float* dsk = P.in[base + 9] + g * 16;
    LAS float* apr = (LAS float*)lds;
    LAS float* api = apr + 64 * 17;
    LAS float* bbr = api + 64 * 17;
    LAS float* bbi = bbr + 1024;
    LAS float* km = bbi + 1024;
    LAS float* crs = km + 4096;
    LAS float* cis = crs + 1024;
    LAS float* cof = cis + 1024;
    const double step = exp((double)log_step[g]);
    for (int e = tid; e < 1024; e += 512) { crs[e] = c_re[e]; cis[e] = c_im[e]; }
    for (int e = tid; e < 64 * 17; e += 512) { const int p = e / 17, k = e % 17; const double mag = exp((double)k * step * (double)a_re[p]), ang = (double)k * step * (double)a_im[p];
        apr[e] = (float)(mag * cos(ang)); api[e] = (float)(mag * sin(ang)); }
    if (tid < 64) { const int p = tid; const double lr = a_re[p], li = a_im[p]; const double mag = exp(step * lr), ang = step * li;
        const double er = mag * cos(ang) - 1.0, ei = mag * sin(ang); const double den = (lr * lr + li * li) * step;
        cof[2 * p] = (float)((er * lr + ei * li) / den); cof[2 * p + 1] = (float)((ei * lr - er * li) / den); }
    __syncthreads();
    for (int e = tid; e < 1024; e += 512) { const int p = e >> 4; const float cr = cof[2 * p], ci = cof[2 * p + 1]; const float br = b_re[e], bi = b_im[e];
        bbr[e] = cr * br - ci * bi; bbi[e] = cr * bi + ci * br; }
    __syncthreads();
    for (int e = tid; e < 4096; e += 512) { const int lag = e >> 8, c = (e >> 4) & 15, cp = e & 15; float s = 0.f;
        for (int p = 0; p < 64; ++p) { const float ar = apr[p * 17 + lag], ai = api[p * 17 + lag], br = bbr[p * 16 + cp], bi = bbi[p * 16 + cp];
            const float wr_ = ar * br - ai * bi, wi_ = ar * bi + ai * br; s += crs[c * 64 + p] * wr_ - cis[c * 64 + p] * wi_; }
        km[e] = s; }
    __syncthreads();
    h16* bt3 = (h16*)(P.ws + WS_BT3) + (size_t)(L * 64 + g) * 256 * 384;
    const float inv_step = (float)(1.0 / step);
    for (int e = tid; e < 256 * 384; e += 512) { const int n = e / 384, k = e % 384, t = n >> 4, c = n & 15; float v;
        if (k < 256) { const int s = k >> 4, cp = k & 15; v = (s <= t) ? km[((t - s) << 8) + (c << 4) + cp] : 0.f; if (s == t && c == cp) v += dsk[c] * inv_step; }
        else { const int kk = k - 256, p = kk & 63; const float ar = apr[p * 17 + t + 1], ai = api[p * 17 + t + 1], cr = crs[c * 64 + p], ci = cis[c * 64 + p];
            v = (kk < 64) ? (cr * ar - ci * ai) : -(cr * ai + ci * ar); }
        bt3[e] = (h16)v; }
    h16* bt1 = (h16*)(P.ws + WS_BT1) + (size_t)(L * 64 + g) * 256 * 256;
    for (int e = tid; e < 65536; e += 512) { const int n = e >> 8, k = e & 255, s = k >> 4, c = k & 15; float v = 0.f;
        if (n < 128) { const int p = n & 63; const float ar = apr[p * 17 + 15 - s], ai = api[p * 17 + 15 - s], br = bbr[p * 16 + c], bi = bbi[p * 16 + c];
            v = (n < 64) ? (ar * br - ai * bi) : (ar * bi + ai * br); }
        bt1[e] = (h16)v; }
    if (tid < 64) { const int p = tid; f32x2* a16 = (f32x2*)(P.ws + WS_A16) + (L * 64 + g) * 64; f32x2* asg = (f32x2*)(P.ws + WS_ASEG) + (L * 64 + g) * 64;
        a16[p] = (f32x2){apr[p * 17 + 16], api[p * 17 + 16]};
        const double mag = exp(2048.0 * step * (double)a_re[p]), ang = 2048.0 * step * (double)a_im[p]; asg[p] = (f32x2){(float)(mag * cos(ang)), (float)(mag * sin(ang))}; }
    if (tid == 0) ((float*)(P.ws + WS_STEP))[L * 64 + g] = (float)step;
    __syncthreads();
}

__device__ __forceinline__ void prep_phase(const Params& P, LAS unsigned char* lds, const int wave_s) {
    const int tid = get_tid(wave_s);
    const int lane = tid & 63, wave = tid >> 6, G = gridDim.x;
    const int gw = blockIdx.x * 8 + wave, NGW = G * 8;
    for (int it = blockIdx.x; it < 128; it += G) ssm_prep_item(P, it >> 6, it & 63, lds, tid);
    __syncthreads();
    { float* ss = (float*)(P.ws + WS_SUMSQ) + M_TOK; for (size_t i = (size_t)blockIdx.x * 512 + tid; i < (size_t)4 * M_TOK; i += (size_t)G * 512) ss[i] = 0.f; }
    if (blockIdx.x == 0) { if (tid < 256) ((unsigned*)(P.ws + WS_CNT))[tid] = 0u; for (int i = tid; i < XCD_BAR_WORDS; i += 512) ((unsigned*)(P.ws + WS_BAR))[i] = 0u; }
    { f32x2* rope = (f32x2*)(P.ws + WS_ROPE);
      for (int e = blockIdx.x * 512 + tid; e < SEQ * 32; e += G * 512) { const int l = e >> 5, i = e & 31; const float inv = (float)pow(10000.0, -(double)(2 * i) / 64.0); const float ang = (float)l * inv;
          rope[e] = (f32x2){(float)cos((double)ang), (float)sin((double)ang)}; } }
    LAS float* scr = (LAS float*)(lds + wave * 8704);
    constexpr int I_IN_S = 16 * 64, I_SQ = 16 * 32, I_IN_A = 16 * 72;
    constexpr int NITEMS = 2 * (I_IN_S + 2 * I_SQ) + 2 * (I_IN_A + I_SQ);
    unsigned char* ws = P.ws;
    for (int it = gw; it < NITEMS; it += NGW) {
        int r = it;
        if (r < I_IN_S) { transpose_item<0>(P.in[2], 1024, 2048, (h16*)(ws + W_IN0), P.in[1], scr, r, lane); continue; } r -= I_IN_S;
        if (r < I_SQ) { transpose_item<0>(P.in[11], 1024, 1024, (h16*)(ws + W_GLU0), nullptr, scr, r, lane); continue; } r -= I_SQ;
        if (r < I_SQ) { transpose_item<0>(P.in[13], 1024, 1024, (h16*)(ws + W_OUT0), nullptr, scr, r, lane); continue; } r -= I_SQ;
        if (r < I_IN_A) { transpose_item<1>(P.in[15], 1024, 2304, (h16*)(ws + W_IN1), P.in[14], scr, r, lane); continue; } r -= I_IN_A;
        if (r < I_SQ) { transpose_item<0>(P.in[17], 1024, 1024, (h16*)(ws + W_OUT1), nullptr, scr, r, lane); continue; } r -= I_SQ;
        if (r < I_IN_S) { transpose_item<0>(P.in[19], 1024, 2048, (h16*)(ws + W_IN2), P.in[18], scr, r, lane); continue; } r -= I_IN_S;
        if (r < I_SQ) { transpose_item<0>(P.in[28], 1024, 1024, (h16*)(ws + W_GLU2), nullptr, scr, r, lane); continue; } r -= I_SQ;
        if (r < I_SQ) { transpose_item<0>(P.in[30], 1024, 1024, (h16*)(ws + W_OUT2), nullptr, scr, r, lane); continue; } r -= I_SQ;
        if (r < I_IN_A) { transpose_item<1>(P.in[32], 1024, 2304, (h16*)(ws + W_IN3), P.in[31], scr, r, lane); continue; } r -= I_IN_A;
        transpose_item<0>(P.in[34], 1024, 1024, (h16*)(ws + W_OUT3), nullptr, scr, r, lane);
    }
    { const float* x = P.in[0]; h16* xh = (h16*)(ws + WS_XH); float* ss0 = (float*)(ws + WS_SUMSQ);
      for (int row = gw; row < M_TOK; row += NGW) { const f32x4* xr = (const f32x4*)(x + (size_t)row * DM) + lane; h4* o = (h4*)(xh + (size_t)row * DM) + lane; float s = 0.f;
#pragma unroll
          for (int j = 0; j < 4; ++j) { const f32x4 v = xr[64 * j]; s += (v[0] * v[0] + v[1] * v[1]) + (v[2] * v[2] + v[3] * v[3]); h4 hv; hv[0] = (h16)v[0]; hv[1] = (h16)v[1]; hv[2] = (h16)v[2]; hv[3] = (h16)v[3]; o[64 * j] = hv; }
          s = wave_sum(s); if (lane == 0) ss0[row] = s; } }
}

__device__ __forceinline__ void s2_phase(const Params& P, int L, LAS unsigned char* lds, const int wave_s) {
    const int tid = get_tid(wave_s);
    const int lane = tid & 63, wave = tid >> 6, seg = wave & 3;
    LAS f32x2* E = (LAS f32x2*)lds;
    for (int gb0 = blockIdx.x * 2; gb0 < 512; gb0 += gridDim.x * 2) {
        const int gb = gb0 + (wave >> 2), g = gb >> 3, b = gb & 7;
        const f32x2 a = ((const f32x2*)(P.ws + WS_A16))[(L * 64 + g) * 64 + lane];
        const f32x2 as = ((const f32x2*)(P.ws + WS_ASEG))[(L * 64 + g) * 64 + lane];
        const float* Gp = (const float*)(P.ws + WS_GP) + ((size_t)g * ROWS_G + b * 512 + seg * 128) * 128 + lane;
        float hr = 0.f, hi = 0.f;
        for (int n = 0; n < 128; n += 8) {
            float gr[8], gi[8];
#pragma unroll
            for (int j = 0; j < 8; ++j) { gr[j] = Gp[(size_t)(n + j) * 128]; gi[j] = Gp[(size_t)(n + j) * 128 + 64]; }
#pragma unroll
            for (int j = 0; j < 8; ++j) { const float t = a.x * hr - a.y * hi + gr[j]; hi = a.x * hi + a.y * hr + gi[j]; hr = t; }
        }
        E[wave * 64 + lane] = (f32x2){hr, hi};
        __syncthreads();
        float sr = 0.f, si = 0.f;
        for (int i = 0; i < seg; ++i) { const f32x2 e = E[((wave & ~3) + i) * 64 + lane]; const float t = as.x * sr - as.y * si + e.x; si = as.x * si + as.y * sr + e.y; sr = t; }
        h16* H = (h16*)(P.ws + WS_UH) + ((size_t)g * ROWS_G + b * 512 + seg * 128) * UHK + 256 + lane;
        hr = sr; hi = si;
        for (int n = 0; n < 128; n += 8) {
            float gr[8], gi[8];
#pragma unroll
            for (int j = 0; j < 8; ++j) { gr[j] = Gp[(size_t)(n + j) * 128]; gi[j] = Gp[(size_t)(n + j) * 128 + 64]; }
#pragma unroll
            for (int j = 0; j < 8; ++j) { H[(size_t)(n + j) * UHK] = (h16)hr; H[(size_t)(n + j) * UHK + 64] = (h16)hi;
                const float t = a.x * hr - a.y * hi + gr[j]; hi = a.x * hi + a.y * hr + gi[j]; hr = t; }
        }
        __syncthreads();
    }
}

__device__ __forceinline__ int crow(int r, int hi) { return (r & 3) + 8 * (r >> 2) + 4 * hi; }
__device__ __forceinline__ void attn_phase(const Params& P, int layer, LAS unsigned char* lds, const int wave_s) {
    const h16* q = (const h16*)(P.ws + WS_UH); const h16* k = (const h16*)(P.ws + WS_K); const h16* vt = (const h16*)(P.ws + WS_VT);
    const h16* gate = (const h16*)(P.ws + WS_GATE); h16* og = (h16*)(P.ws + WS_OG);
    const float* sinks = P.in[layer == 1 ? 16 : 33];
    const int tid = get_tid(wave_s);
    const int lane = tid & 63, wave = __builtin_amdgcn_readfirstlane(tid >> 6), l31 = lane & 31, hi = lane >> 5;
    LAS h16* Ks = (LAS h16*)lds;
    LAS h16* Vs = (LAS h16*)(lds + 36864);
    LAS h16* Os = (LAS h16*)(lds + 70144) + wave * (32 * 72);
    const int G = gridDim.x;
    int unit = blockIdx.x;
    if (unit >= 1024) return;
    unsigned m0 = 0;
#pragma unroll
    for (int r = 0; r < 16; ++r) if (crow(r, hi) > l31) m0 |= 1u << r;
    const int grow = lane >> 3, gcol = (lane & 7) * 8;
    h8 kvr[8];
#define ATT_LOADKV(U) do { const int kvh_ = (U) & 1, blk_ = ((U) >> 1) & 63, b_ = (U) >> 7; \
        _Pragma("unroll") for (int c_ = 0; c_ < 4; ++c_) { const int id = tid + 512 * c_, key = id >> 3, part = id & 7; const int l = blk_ * 128 - 128 + key; \
            kvr[c_] = (h8)(h16)0.f; if (l >= 0) kvr[c_] = *(const h8*)(k + ((size_t)b_ * SEQ + l) * 128 + kvh_ * 64 + part * 8); } \
        _Pragma("unroll") for (int c_ = 0; c_ < 4; ++c_) { const int id = tid + 512 * c_, d = id >> 5, part = id & 31; const int l0 = blk_ * 128 - 128 + part * 8; \
            kvr[4 + c_] = (h8)(h16)0.f; if (l0 >= 0) kvr[4 + c_] = *(const h8*)(vt + ((size_t)((b_ * 2 + kvh_) * 64 + d)) * SEQ + l0); } } while (0)
#define ATT_STOREKV() do { \
        _Pragma("unroll") for (int c_ = 0; c_ < 4; ++c_) { const int id = tid + 512 * c_, key = id >> 3, part = id & 7; *(LAS h8*)(Ks + key * 72 + part * 8) = kvr[c_]; } \
        _Pragma("unroll") for (int c_ = 0; c_ < 4; ++c_) { const int id = tid + 512 * c_, d = id >> 5, part = id & 31; LAS h16* dst = Vs + d * 260 + part * 8; *(LAS h4*)dst = kvr[4 + c_].lo; *(LAS h4*)(dst + 4) = kvr[4 + c_].hi; } } while (0)
#define ATT_LOADQ(U, I) do { const int kvh_ = (U) & 1, blk_ = ((U) >> 1) & 63, b_ = (U) >> 7; const h16* qp = q + ((size_t)b_ * SEQ + blk_ * 128 + 32 * (I) + l31) * DM + (kvh_ * 8 + wave) * 64 + 8 * hi; \
        _Pragma("unroll") for (int ds = 0; ds < 4; ++ds) qf[ds] = *(const h8*)(qp + 16 * ds); } while (0)
    h8 qf[4];
    ATT_LOADKV(unit);
    ATT_LOADQ(unit, 0);
    ATT_STOREKV();
    __syncthreads();
    for (;;) {
        const int kvh = unit & 1, blk = (unit >> 1) & 63, b = unit >> 7, hq = kvh * 8 + wave;
        const float sink2 = sinks[hq] * LOG2E;
        const int nunit = unit + G; const bool has_next = nunit < 1024;
#pragma unroll
        for (int i = 0; i < 4; ++i) {
            const size_t tok0 = (size_t)b * SEQ + blk * 128 + 32 * i;
            if (i == 3 && has_next) ATT_LOADKV(nunit);
            f32x16 s[5];
#pragma unroll
            for (int t5 = 0; t5 < 5; ++t5) { f32x16 a16;
#pragma unroll
                for (int r = 0; r < 16; ++r) a16[r] = 0.f;
#pragma unroll
                for (int ds = 0; ds < 4; ++ds) { const h8 kf = *(const LAS h8*)(Ks + (32 * (i + t5) + l31) * 72 + 16 * ds + 8 * hi); a16 = __builtin_amdgcn_mfma_f32_32x32x16_f16(kf, qf[ds], a16, 0, 0, 0); }
                s[t5] = a16; }
            h8 gt[4];
#pragma unroll
            for (int j = 0; j < 4; ++j) gt[j] = *(const h8*)(gate + (tok0 + grow + 8 * j) * DM + hq * 64 + gcol);
#pragma unroll
            for (int r = 0; r < 16; ++r) { const bool in0 = (m0 >> r) & 1u; s[0][r] = in0 ? s[0][r] : -1e30f; s[4][r] = in0 ? -1e30f : s[4][r]; }
            if (blk == 0) {
#pragma unroll
                for (int t5 = 0; t5 < 4; ++t5) if (i + t5 < 4) {
#pragma unroll
                    for (int r = 0; r < 16; ++r) s[t5][r] = -1e30f; }
            }
            float mx = sink2;
#pragma unroll
            for (int t5 = 0; t5 < 5; ++t5)
#pragma unroll
                for (int r = 0; r < 16; ++r) mx = fmaxf(mx, s[t5][r]);
            mx = fmaxf(mx, __shfl_xor(mx, 32));
            float sum = 0.f;
#pragma unroll
            for (int t5 = 0; t5 < 5; ++t5)
#pragma unroll
                for (int r = 0; r < 16; ++r) { const float p = __builtin_amdgcn_exp2f(s[t5][r] - mx); s[t5][r] = p; sum += p; }
            sum += __shfl_xor(sum, 32);
            sum += __builtin_amdgcn_exp2f(sink2 - mx);
            const float inv = __builtin_amdgcn_rcpf(sum);
            f32x16 o0, o1;
#pragma unroll
            for (int r = 0; r < 16; ++r) { o0[r] = 0.f; o1[r] = 0.f; }
#pragma unroll
            for (int t5 = 0; t5 < 5; ++t5)
#pragma unroll
                for (int ss = 0; ss < 2; ++ss) { h8 pf;
#pragma unroll
                    for (int j = 0; j < 8; ++j) pf[j] = (h16)(s[t5][8 * ss + j] * inv);
                    const int kb = 32 * (i + t5) + 16 * ss + 4 * hi;
                    { const LAS h16* vp = Vs + l31 * 260 + kb; const h4 lo = *(const LAS h4*)vp, hi4 = *(const LAS h4*)(vp + 8);
                      const h8 vf = __builtin_shufflevector(lo, hi4, 0, 1, 2, 3, 4, 5, 6, 7); o0 = __builtin_amdgcn_mfma_f32_32x32x16_f16(pf, vf, o0, 0, 0, 0); }
                    { const LAS h16* vp = Vs + (32 + l31) * 260 + kb; const h4 lo = *(const LAS h4*)vp, hi4 = *(const LAS h4*)(vp + 8);
                      const h8 vf = __builtin_shufflevector(lo, hi4, 0, 1, 2, 3, 4, 5, 6, 7); o1 = __builtin_amdgcn_mfma_f32_32x32x16_f16(pf, vf, o1, 0, 0, 0); } }
            if (i < 3) ATT_LOADQ(unit, i + 1); else if (has_next) ATT_LOADQ(nunit, 0);
#pragma unroll
            for (int r = 0; r < 16; ++r) { LAS h16* op = Os + crow(r, hi) * 72 + l31; op[0] = (h16)o0[r]; op[32] = (h16)o1[r]; }
#pragma unroll
            for (int j = 0; j < 4; ++j) { const h8 ov = *(const LAS h8*)(Os + (grow + 8 * j) * 72 + gcol); h8 res;
#pragma unroll
                for (int e = 0; e < 8; ++e) { const float g = (float)gt[j][e]; res[e] = (h16)((float)ov[e] * g * sigmoidf_(g)); }
                *(h8*)(og + (tok0 + grow + 8 * j) * DM + hq * 64 + gcol) = res; }
        }
        if (!has_next) break;
        __syncthreads();
        ATT_STOREKV();
        __syncthreads();
        unit = nunit;
    }
#undef ATT_LOADKV
#undef ATT_STOREKV
#undef ATT_LOADQ
}

__device__ __forceinline__ void final_norm_phase(const Params& P, const int wave_s) {
    const int tid = get_tid(wave_s);
    const int lane = tid & 63, wave = tid >> 6; const int gw = blockIdx.x * 8 + wave, NGW = gridDim.x * 8;
    const float* ss = (const float*)(P.ws + WS_SUMSQ) + (size_t)4 * M_TOK; const f32x4* gn = (const f32x4*)P.in[35];
    f32x4 gv[4];
#pragma unroll
    for (int j = 0; j < 4; ++j) gv[j] = gn[64 * j + lane];
    for (int row = gw; row < M_TOK; row += NGW) { const float rs = rsqrtf(ss[row] * (1.0f / DM) + NORM_EPS); f32x4* xr = (f32x4*)(P.out + (size_t)row * DM) + lane;
#pragma unroll
        for (int j = 0; j < 4; ++j) { const f32x4 v = xr[64 * j]; xr[64 * j] = v * rs * gv[j]; } }
}


#define XB_TMO      128
#define XB_XCNT(j)  (256  + 64 * (j))
#define XB_XSUB(j)  (1280 + 64 * (j))
#define XB_XGEN(j)  (2304 + 64 * (j))
#define XB_TOP      3328
#define XB_TOPGEN   3392
#define XB_SPIN_CAP (1u << 22)
__device__ __forceinline__ unsigned xb_ld(unsigned* p)              { return __hip_atomic_load(p, __ATOMIC_RELAXED, __HIP_MEMORY_SCOPE_AGENT); }
__device__ __forceinline__ unsigned xb_add(unsigned* p, unsigned v) { return __hip_atomic_fetch_add(p, v, __ATOMIC_RELAXED, __HIP_MEMORY_SCOPE_AGENT); }
__device__ __forceinline__ unsigned xb_xcc_id() { return (unsigned)__builtin_amdgcn_s_getreg((3 << 11) | 20) & 0xFu; }
#define XB_SPIN(cond, bar) do { unsigned _sp = 0; while (cond) { __builtin_amdgcn_s_sleep(1); \
    if ((++_sp & 255u) == 0u) { if (xb_ld(&(bar)[XB_TMO])) break; if (_sp > XB_SPIN_CAP) { atomicAdd(&(bar)[XB_TMO], 1u); break; } } } } while (0)
struct XcdBarrier { unsigned* bar; unsigned x; volatile LAS unsigned* st; };
__device__ __forceinline__ XcdBarrier xcd_barrier_post(unsigned* bar, volatile LAS unsigned* st, int tid) {
    XcdBarrier b; b.bar = bar; b.x = xb_xcc_id(); b.st = st;
    if (tid == 0) (void)xb_add(&bar[XB_XCNT(b.x)], 1u);
    return b;
}
__device__ __forceinline__ void xcd_barrier_complete(unsigned* bar, unsigned x, unsigned& nloc, unsigned& nx) {
    const unsigned G = gridDim.x * gridDim.y * gridDim.z;
    unsigned sum, cnt, mine, sp = 0u;
    for (;;) {
        sum = 0u; cnt = 0u; mine = 0u;
#pragma unroll
        for (unsigned j = 0; j < 16; ++j) { const unsigned c = xb_ld(&bar[XB_XCNT(j)]); sum += c; cnt += (c > 0u) ? 1u : 0u; mine = (j == x) ? c : mine; }
        if (sum == G) break;
        __builtin_amdgcn_s_sleep(1);
        if ((++sp & 255u) == 0u) { if (xb_ld(&bar[XB_TMO])) break; if (sp > XB_SPIN_CAP) { atomicAdd(&bar[XB_TMO], 1u); break; } }
    }
    nloc = mine > 0u ? mine : 1u; nx = cnt > 0u ? cnt : 1u;
}
__device__ __forceinline__ void xcd_barrier(const XcdBarrier& b, int wave_s) {
    asm volatile("s_waitcnt vmcnt(0)" ::: "memory");
    __syncthreads();
    if (get_tid(wave_s) == 0) {
        unsigned* bar = b.bar;
        __builtin_amdgcn_s_waitcnt(0);
        unsigned nloc = b.st[0], nx = b.st[1];
        if (nloc == 0u) { xcd_barrier_complete(bar, b.x, nloc, nx); b.st[0] = nloc; b.st[1] = nx; }
        const unsigned old = xb_add(&bar[XB_XSUB(b.x)], 1u);
        const unsigned gen = old / nloc;
        if (old + 1u == (gen + 1u) * nloc) {
            __builtin_amdgcn_fence(__ATOMIC_RELEASE, "agent");
            asm volatile("s_waitcnt vmcnt(0)" ::: "memory");
            const unsigned og = xb_add(&bar[XB_TOP], 1u);
            const unsigned tg = og / nx;
            if (og + 1u == (tg + 1u) * nx) xb_add(&bar[XB_TOPGEN], 1u);
            else XB_SPIN(xb_ld(&bar[XB_TOPGEN]) == tg, bar);
            __builtin_amdgcn_fence(__ATOMIC_ACQUIRE, "agent");
            xb_add(&bar[XB_XGEN(b.x)], 1u);
            asm volatile("s_waitcnt vmcnt(0)" ::: "memory");
        } else {
            XB_SPIN(xb_ld(&bar[XB_XGEN(b.x)]) == gen, bar);
            __builtin_amdgcn_fence(__ATOMIC_ACQUIRE, "agent");
            asm volatile("s_waitcnt vmcnt(0)" ::: "memory");
        }
    }
    __syncthreads();
}

#ifndef PROBE_PHASE
#define PROBE_PHASE -1
#endif
#define PROBE_K 8
#define PB(id) do { if (PROBE_PHASE == (id) && layer < 2) pt0 = __builtin_amdgcn_s_memrealtime(); } while (0)
#define SYNC(id) do { xcd_barrier(bar, wave_s); if (PROBE_PHASE == (id) && layer < 2 && blockIdx.x == 0) { const unsigned long long t1 = __builtin_amdgcn_s_memrealtime(); const unsigned long long dt = (t1 - pt0) * PROBE_K; \
    while (__builtin_amdgcn_s_memrealtime() - t1 < dt) __builtin_amdgcn_s_sleep(8); } } while (0)
constexpr int LDS_BYTES = 135168;
__global__ void __launch_bounds__(512) fwd_megakernel(Params P) {
    extern __shared__ __attribute__((aligned(16))) unsigned char lds_raw[];
    LAS unsigned char* lds = (LAS unsigned char*)lds_raw;
    cg::grid_group grid = cg::this_grid();
    const int wave_s = __builtin_amdgcn_readfirstlane((int)(threadIdx.x >> 6));
    const int G = gridDim.x, c = blockIdx.x;
    volatile LAS unsigned* bst = (volatile LAS unsigned*)(lds + 131072);
    if (threadIdx.x < 2) bst[threadIdx.x] = 0u;
    __syncthreads();
    unsigned char* ws = P.ws;
    float* sumsq = (float*)(ws + WS_SUMSQ);
    h16* xh = (h16*)(ws + WS_XH); h16* UH = (h16*)(ws + WS_UH); float* Gp = (float*)(ws + WS_GP); h16* gate = (h16*)(ws + WS_GATE);
    h16* Zg = (h16*)(ws + WS_ZG); h16* og = (h16*)(ws + WS_OG);
    const AGeo plainA{2048u, 32u, 128};

#ifndef PH_MASK
#define PH_MASK 0xFFFF
#endif
    unsigned long long pt0 = 0;
    if (PH_MASK & 1) prep_phase(P, lds, wave_s);
    grid.sync();
    const XcdBarrier bar = xcd_barrier_post((unsigned*)(ws + WS_BAR), bst, get_tid(wave_s));

#pragma unroll 1
    for (int layer = 0; layer < 4; ++layer) {
        if ((layer & 1) == 0) {
            const int L = layer >> 1;
            const unsigned char* win = ws + (L ? W_IN2 : W_IN0); const unsigned char* wglu = ws + (L ? W_GLU2 : W_GLU0); const unsigned char* wout = ws + (L ? W_OUT2 : W_OUT0);
            const float* bglu = P.in[L ? 29 : 12];
            { PlainOrder S; S.init(M_TOK, 2048, G, c, xh, (size_t)256 * 2048, win, (size_t)256 * 2048);
              EpiG1Ssm E{sumsq + (size_t)layer * M_TOK, UH, gate};
              PB(1); if (PH_MASK & 2) gemm_phase(lds, wave_s, plainA, 2048u, 16, S, E); }
            SYNC(1);
            { GroupOrder S{G, c, (const char*)UH, (const char*)(ws + WS_BT1) + (size_t)L * 64 * 256 * 256 * 2, (size_t)ROWS_G * UHK * 2, (size_t)256 * 256 * 2, (size_t)256 * UHK * 2};
              EpiS1 E{Gp};
              PB(2); if (PH_MASK & 4) gemm_phase(lds, wave_s, AGeo{UHK * 2u, 32u, 128}, 512u, 4, S, E); }
            SYNC(2);
            PB(3); if (PH_MASK & 8) s2_phase(P, L, lds, wave_s);
            SYNC(3);
            { GroupOrder S{G, c, (const char*)UH, (const char*)(ws + WS_BT3) + (size_t)L * 64 * 256 * 384 * 2, (size_t)ROWS_G * UHK * 2, (size_t)256 * 384 * 2, (size_t)256 * UHK * 2};
              EpiS3 E{(const float*)(ws + WS_STEP) + L * 64, Zg};
              PB(4); if (PH_MASK & 16) gemm_phase(lds, wave_s, AGeo{UHK * 2u, 32u, 128}, 768u, 6, S, E); }
            SYNC(4);
            { PlainOrder S; S.init(M_TOK, 1024, G, c, Zg, (size_t)256 * 32, wglu, (size_t)256 * 2048);
              EpiGlu E{Zg, gate, bglu, og};
              PB(5); if (PH_MASK & 32) gemm_phase(lds, wave_s, AGeo{32u, (unsigned)(M_TOK * 32), (size_t)4 * M_TOK * 32}, 2048u, 16, S, E); }
            SYNC(5);
            { PlainOrder S; S.init(M_TOK, 1024, G, c, og, (size_t)256 * 2048, wout, (size_t)256 * 2048);
              EpiOut E{xh, sumsq + (size_t)(layer + 1) * M_TOK};
              PB(6); if (PH_MASK & 64) gemm_phase(lds, wave_s, plainA, 2048u, 16, S, E); }
            SYNC(6);
        } else {
            const unsigned char* win = ws + (layer == 1 ? W_IN1 : W_IN3); const unsigned char* wout = ws + (layer == 1 ? W_OUT1 : W_OUT3);
            { PlainOrder S; S.init(M_TOK, 2304, G, c, xh, (size_t)256 * 2048, win, (size_t)256 * 2048);
              EpiG1Att E{sumsq + (size_t)layer * M_TOK, (const f32x2*)(ws + WS_ROPE), (h16*)(ws + WS_UH), (h16*)(ws + WS_K), (h16*)(ws + WS_VT), gate};
              PB(7); if (PH_MASK & 128) gemm_phase(lds, wave_s, plainA, 2048u, 16, S, E); }
            SYNC(7);
            PB(8); if (PH_MASK & 256) attn_phase(P, layer, lds, wave_s);
            SYNC(8);
            { PlainOrder S; S.init(M_TOK, 1024, G, c, og, (size_t)256 * 2048, wout, (size_t)256 * 2048);
              if (layer == 1) { EpiOut E{xh, sumsq + (size_t)(layer + 1) * M_TOK};
                PB(9); if (PH_MASK & 512) gemm_phase(lds, wave_s, plainA, 2048u, 16, S, E); }
              else if (G == 256) { EpiOutFinal E{xh, P.out, sumsq + (size_t)4 * M_TOK, (unsigned*)(ws + WS_CNT), P.in[35]};
                gemm_phase(lds, wave_s, plainA, 2048u, 16, S, E); }
              else { EpiOutLast E{xh, P.out, sumsq + (size_t)4 * M_TOK};
                gemm_phase(lds, wave_s, plainA, 2048u, 16, S, E); } }
            if (!(layer == 3 && G == 256)) SYNC(9);
        }
    }
    { const int layer = 0; PB(10); if ((PH_MASK & 1024) && G != 256) final_norm_phase(P, wave_s);
      if (PROBE_PHASE == 10 && blockIdx.x == 0) { const unsigned long long t1 = __builtin_amdgcn_s_memrealtime(); const unsigned long long dt = (t1 - pt0) * PROBE_K; while (__builtin_amdgcn_s_memrealtime() - t1 < dt) __builtin_amdgcn_s_sleep(8); } }
}

extern "C" void kernel_launch(void* const* d_in, const int* in_sizes, int n_in, void* d_out, int out_size, void* d_ws, size_t ws_size, hipStream_t stream) {
    static int grid_blocks = 0;
    if (grid_blocks == 0) {
        if (n_in != 36 || ws_size < WS_END) { fprintf(stderr, "kernel_launch: unexpected n_in %d / ws %zu\n", n_in, ws_size); grid_blocks = -1; return; }
        int dev = 0, cus = 0, per_cu = 0;
        hipGetDevice(&dev);
        hipDeviceGetAttribute(&cus, hipDeviceAttributeMultiprocessorCount, dev);
        hipFuncSetAttribute((const void*)fwd_megakernel, hipFuncAttributeMaxDynamicSharedMemorySize, LDS_BYTES);
        hipOccupancyMaxActiveBlocksPerMultiprocessor(&per_cu, (const void*)fwd_megakernel, 512, LDS_BYTES);
        if (per_cu < 1) per_cu = 1;
        grid_blocks = cus * per_cu;
        (void)hipGetLastError();
    }
    if (grid_blocks < 0) return;
    Params p{};
    for (int i = 0; i < 36; ++i) p.in[i] = (const float*)d_in[i];
    p.out = (float*)d_out; p.ws = (unsigned char*)d_ws;
    void* args[] = {&p};
    hipError_t e = hipLaunchCooperativeKernel((const void*)fwd_megakernel, dim3(grid_blocks), dim3(512), args, LDS_BYTES, stream);
    if (e != hipSuccess) fprintf(stderr, "cooperative launch failed: %s (grid %d)\n", hipGetErrorString(e), grid_blocks);
}
```

```cpp
#include <hip/hip_runtime.h>
#include <hip/hip_cooperative_groups.h>
#include <cstdint>
#include <cstdio>
namespace cg = cooperative_groups;

#define LAS __attribute__((address_space(3)))
typedef _Float16 h16;
typedef _Float16 h8 __attribute__((ext_vector_type(8)));
typedef _Float16 h4 __attribute__((ext_vector_type(4)));
typedef float f32x4 __attribute__((ext_vector_type(4)));
typedef float f32x2 __attribute__((ext_vector_type(2)));
typedef float f32x16 __attribute__((ext_vector_type(16)));

__device__ __forceinline__ int get_tid(int wave_s) { int t = wave_s * 64 + (int)__builtin_amdgcn_mbcnt_hi(~0u, __builtin_amdgcn_mbcnt_lo(~0u, 0u)); asm volatile("" : "+v"(t)); return t; }

constexpr int M_TOK = 65536, DM = 1024, SEQ = 8192;
constexpr int ROWS_G = 4096;
constexpr int UHK = 384;
constexpr float NORM_EPS = 1e-5f;
constexpr float LOG2E = 1.4426950408889634f;

constexpr size_t MiB = 1u << 20;
constexpr size_t WS_SUMSQ = 0;
constexpr size_t WS_ROPE  = 2 * MiB;
constexpr size_t WS_A16   = 4 * MiB;
constexpr size_t WS_ASEG  = 4 * MiB + 65536;
constexpr size_t WS_STEP  = 4 * MiB + 131072;
constexpr size_t WS_BAR   = 5 * MiB;
constexpr size_t WS_CNT   = 4 * MiB + 196608;
constexpr size_t WS_W     = 8 * MiB;
constexpr size_t W_IN0 = WS_W, W_GLU0 = W_IN0 + 4 * MiB, W_OUT0 = W_GLU0 + 2 * MiB;
constexpr size_t W_IN1 = W_OUT0 + 2 * MiB, W_OUT1 = W_IN1 + 5 * MiB;
constexpr size_t W_IN2 = W_OUT1 + 2 * MiB, W_GLU2 = W_IN2 + 4 * MiB, W_OUT2 = W_GLU2 + 2 * MiB;
constexpr size_t W_IN3 = W_OUT2 + 2 * MiB, W_OUT3 = W_IN3 + 5 * MiB;
constexpr size_t WS_BT1 = 40 * MiB;
constexpr size_t WS_BT3 = 56 * MiB;
constexpr size_t WS_XH  = 80 * MiB;
constexpr size_t WS_UH  = 208 * MiB;
constexpr size_t WS_GP  = 400 * MiB;
constexpr size_t WS_K   = WS_GP, WS_VT = WS_GP + 32 * MiB;
constexpr size_t WS_GATE = 528 * MiB;
constexpr size_t WS_ZG  = 656 * MiB;
constexpr size_t WS_OG  = 784 * MiB;
constexpr size_t WS_END = 912 * MiB;

#define XCD_BAR_WORDS 3456
struct Params { const float* in[36]; float* out; unsigned char* ws; };
extern __shared__ __attribute__((aligned(16))) unsigned char lds_raw[];
struct PV {
    __device__ __forceinline__ unsigned long long get(int i) const { const unsigned long long v = ((volatile LAS unsigned long long*)((LAS unsigned char*)lds_raw + 131072 + 16))[i]; const unsigned lo = __builtin_amdgcn_readfirstlane((unsigned)v), hi = __builtin_amdgcn_readfirstlane((unsigned)(v >> 32)); return ((unsigned long long)hi << 32) | lo; }
    __device__ __forceinline__ const float* in(int i) const { return (const float*)get(i); }
    __device__ __forceinline__ float* out() const { return (float*)get(36); }
    __device__ __forceinline__ unsigned char* ws() const { return (unsigned char*)get(37); }
};

constexpr int BM = 256, BK = 64, HALF = 128, HTB = HALF * BK * 2, STAGE_BYTES = 8 * HTB, NXCD = 8, WGM = 8;
__device__ __forceinline__ int lds_byte(int r, int c) { const int st = (r >> 4) * 2 + (c >> 5), rr = r & 15, cc = c & 31, ob = rr * 64 + cc * 2; return st * 1024 + (ob ^ (((ob >> 9) & 1) << 5)); }
__device__ __forceinline__ void stage_rc(int b, int& R, int& C) { const int st = b / 1024, sb = b % 1024, swz = sb ^ (((sb >> 9) & 1) << 5); R = (st >> 1) * 16 + swz / 64; C = (st & 1) * 32 + (swz % 64) / 2; }
__device__ __forceinline__ int perm32(int rho) { const int n = rho >> 4, i = rho & 15; return 8 * (i >> 2) + 4 * n + (i & 3); }

struct GUnit { const char* a; const char* b; int pm, pn, g; };
struct AGeo { unsigned lda, slab; size_t kstep; };

struct PlainOrder {
    int nM, nN, nwg, G, c; const char* A; const char* B; size_t ta, tb;
    __device__ __forceinline__ void init(int M, int N, int G_, int c_, const void* A_, size_t ta_, const void* B_, size_t tb_) { nM = M / BM; nN = N / BM; nwg = nM * nN; G = G_; c = c_; A = (const char*)A_; B = (const char*)B_; ta = ta_; tb = tb_; }
    __device__ __forceinline__ bool next(int i, GUnit& u) const {
        const long L = (long)i * G + c; if (L >= nwg) return false;
        int wgid = (int)L; { const int q = nwg / NXCD, r = nwg % NXCD, xcd = wgid % NXCD, off = wgid / NXCD; wgid = (xcd < r ? xcd * (q + 1) : r * (q + 1) + (xcd - r) * q) + off; }
        const int nig = WGM * nN, gid = wgid / nig, fm = gid * WGM, gsz = (nM - fm) < WGM ? (nM - fm) : WGM;
        u.pm = fm + ((wgid % nig) % gsz); u.pn = (wgid % nig) / gsz; u.g = 0;
        u.a = A + (size_t)u.pm * ta; u.b = B + (size_t)u.pn * tb; return true;
    }
};
struct GroupOrder {
    int G, c; const char* A; const char* B; size_t gsa, gsb, ta;
    __device__ __forceinline__ bool next(int i, GUnit& u) const {
        const long L = (long)i * G + c; if (L >= 1024) return false;
        int g, pm;
        if (G == 256) { const int xcd = c & 7, j = c >> 3; g = i * 16 + xcd * 2 + (j >> 4); pm = j & 15; }
        else { g = (int)(L >> 4); pm = (int)(L & 15); }
        u.g = g; u.pm = pm; u.pn = 0; u.a = A + (size_t)g * gsa + (size_t)pm * ta; u.b = B + (size_t)g * gsb; return true;
    }
};

template <class Epi, class Sched>
__device__ __forceinline__ void gemm_phase(LAS unsigned char* lds, const int wave_s, const AGeo ga, const unsigned ldb, const int nt, const Sched& S, const Epi& E) {
    const int tid = get_tid(wave_s);
    const int wid = __builtin_amdgcn_readfirstlane(tid >> 6), lane = tid & 63, wr = wid >> 2, wc = wid & 3, fr = lane & 15, fq = lane >> 4;
    unsigned voffA[2], voffB[2];
#pragma unroll
    for (int i = 0; i < 2; ++i) { int R, C; stage_rc(tid * 16 + i * 8192, R, C); const int Rb = (R & ~31) + perm32(R & 31);
        voffA[i] = (unsigned)R * ga.lda + (unsigned)(C >> 4) * ga.slab + (unsigned)(C & 15) * 2u; voffB[i] = (unsigned)Rb * ldb + (unsigned)C * 2u; }
    const size_t kA = ga.kstep, kB = 128;
    const size_t hA = (size_t)HALF * ga.lda, hB = (size_t)HALF * ldb;
    const unsigned ldsw = (unsigned)wid * 1024u;
    const int aoff = lds_byte(wr * 64 + fr, fq * 8), boff = lds_byte(wc * 32 + fr, fq * 8);
#define PG8_SA(b, h) (((b) * 2 + (h)) * HTB)
#define PG8_SB(b, h) ((4 + (b) * 2 + (h)) * HTB)
#define PG8_STAGE(bufoff, gbase, voff) do { _Pragma("unroll") for (int _i = 0; _i < 2; ++_i) \
        __builtin_amdgcn_global_load_lds((const unsigned*)((const char*)(gbase) + (voff)[_i]), (LAS unsigned*)(lds + (bufoff) + ldsw + _i * 8192), 16, 0, 0); } while (0)
#define PG8_LDA(dst, b, h) do { _Pragma("unroll") for (int m = 0; m < 4; ++m) _Pragma("unroll") for (int k = 0; k < 2; ++k) dst[m][k] = *(const LAS h8*)(lds + PG8_SA(b, h) + aoff + m * 2048 + k * 1024); } while (0)
#define PG8_LDB(dst, b, h) do { _Pragma("unroll") for (int n = 0; n < 2; ++n) _Pragma("unroll") for (int k = 0; k < 2; ++k) dst[n][k] = *(const LAS h8*)(lds + PG8_SB(b, h) + boff + n * 2048 + k * 1024); } while (0)
#define PG8_MMA(ai, bj, At, Bt) do { __builtin_amdgcn_s_setprio(1); _Pragma("unroll") for (int m = 0; m < 4; ++m) _Pragma("unroll") for (int n = 0; n < 2; ++n) _Pragma("unroll") for (int k = 0; k < 2; ++k) \
        acc[ai][bj][m][n] = __builtin_amdgcn_mfma_f32_16x16x32_f16(Bt[n][k], At[m][k], acc[ai][bj][m][n], 0, 0, 0); __builtin_amdgcn_s_setprio(0); } while (0)
#define PG8_WAIT_V(n) asm volatile("s_waitcnt vmcnt(" #n ")" ::: "memory")
#define PG8_WAIT_L(n) asm volatile("s_waitcnt lgkmcnt(" #n ")" ::: "memory")
#define PG8_BAR __builtin_amdgcn_s_barrier()
#define PG8_SCHED __builtin_amdgcn_sched_barrier(0)
    GUnit cur, nxt; int ui = 0;
    if (!S.next(0, cur)) return;
    f32x4 acc[2][2][4][2];
#pragma unroll
    for (int a = 0; a < 2; ++a)
#pragma unroll
        for (int b = 0; b < 2; ++b)
#pragma unroll
            for (int m = 0; m < 4; ++m)
#pragma unroll
                for (int n = 0; n < 2; ++n) acc[a][b][m][n] = (f32x4){0.f, 0.f, 0.f, 0.f};
    h8 At[4][2], B0[2][2], B1[2][2];
    const char* cA = cur.a; const char* cB = cur.b;
    PG8_STAGE(PG8_SB(0, 0), cB, voffB); PG8_STAGE(PG8_SB(0, 1), cB + hB, voffB); PG8_STAGE(PG8_SA(0, 0), cA, voffA); PG8_STAGE(PG8_SA(0, 1), cA + hA, voffA);
    if (wr == 1) PG8_BAR;
    PG8_WAIT_V(2); PG8_BAR;
    PG8_STAGE(PG8_SB(1, 0), cB + kB, voffB); PG8_STAGE(PG8_SA(1, 0), cA + kA, voffA); PG8_STAGE(PG8_SB(1, 1), cB + hB + kB, voffB);
    PG8_WAIT_V(6); PG8_BAR;
    for (;;) {
        const bool has_next = S.next(ui + 1, nxt);
        const char* nA = has_next ? nxt.a : cA; const char* nB = has_next ? nxt.b : cB;
#pragma unroll 1
        for (int t = 0; t < nt; t += 2) {
            const bool last = (t == nt - 2);
            const char* a1 = cA + (size_t)(t + 1) * kA;
            const char* a2 = last ? nA : cA + (size_t)(t + 2) * kA; const char* b2 = last ? nB : cB + (size_t)(t + 2) * kB;
            const char* a3 = a2 + kA; const char* b3 = b2 + kB;
            PG8_LDB(B0, 0, 0); PG8_LDB(B1, 0, 1); PG8_SCHED; PG8_LDA(At, 0, 0); PG8_STAGE(PG8_SA(1, 1), a1 + hA, voffA);
            PG8_WAIT_V(8); PG8_WAIT_L(0); PG8_BAR; PG8_MMA(0, 0, At, B0); PG8_MMA(0, 1, At, B1); PG8_BAR; PG8_SCHED;
            PG8_LDA(At, 0, 1); PG8_STAGE(PG8_SB(0, 0), b2, voffB); PG8_STAGE(PG8_SB(0, 1), b2 + hB, voffB); PG8_STAGE(PG8_SA(0, 0), a2, voffA);
            PG8_WAIT_V(8); PG8_WAIT_L(0); PG8_BAR; PG8_MMA(1, 0, At, B0); PG8_MMA(1, 1, At, B1); PG8_BAR; PG8_SCHED;
            PG8_LDB(B0, 1, 0); PG8_LDB(B1, 1, 1); PG8_SCHED; PG8_LDA(At, 1, 0); PG8_STAGE(PG8_SA(0, 1), a2 + hA, voffA);
            PG8_WAIT_V(8); PG8_WAIT_L(0); PG8_BAR; PG8_MMA(0, 0, At, B0); PG8_MMA(0, 1, At, B1); PG8_BAR; PG8_SCHED;
            PG8_LDA(At, 1, 1); PG8_STAGE(PG8_SB(1, 0), b3, voffB); PG8_STAGE(PG8_SB(1, 1), b3 + hB, voffB); PG8_STAGE(PG8_SA(1, 0), a3, voffA);
            PG8_WAIT_V(8); PG8_WAIT_L(0); PG8_BAR; PG8_MMA(1, 0, At, B0); PG8_MMA(1, 1, At, B1); PG8_BAR; PG8_SCHED;
        }
        if (wr == 0) PG8_BAR;
        E(acc, cur, wr, wc, fr, fq);
        if (!has_next) break;
#pragma unroll
        for (int a = 0; a < 2; ++a)
#pragma unroll
            for (int b = 0; b < 2; ++b)
#pragma unroll
                for (int m = 0; m < 4; ++m)
#pragma unroll
                    for (int n = 0; n < 2; ++n) acc[a][b][m][n] = (f32x4){0.f, 0.f, 0.f, 0.f};
        cur = nxt; cA = nA; cB = nB; ++ui;
        if (wr == 1) PG8_BAR;
    }
    PG8_WAIT_V(0);
    PG8_BAR;
#undef PG8_SA
#undef PG8_SB
#undef PG8_STAGE
#undef PG8_LDA
#undef PG8_LDB
#undef PG8_MMA
#undef PG8_WAIT_V
#undef PG8_WAIT_L
#undef PG8_BAR
#undef PG8_SCHED
}

__device__ __forceinline__ h8 pack8(f32x4 a, f32x4 b) { h8 r; r[0] = (h16)a[0]; r[1] = (h16)a[1]; r[2] = (h16)a[2]; r[3] = (h16)a[3]; r[4] = (h16)b[0]; r[5] = (h16)b[1]; r[6] = (h16)b[2]; r[7] = (h16)b[3]; return r; }
__device__ __forceinline__ float sigmoidf_(float x) { return __builtin_amdgcn_rcpf(1.0f + __expf(-x)); }

struct EpiG1Ssm {
    const float* sumsq; h16* UH; h16* gate;
    __device__ __forceinline__ void operator()(const f32x4 (&acc)[2][2][4][2], const GUnit& u, int wr, int wc, int fr, int fq) const {
#pragma unroll
        for (int ai = 0; ai < 2; ++ai)
#pragma unroll
            for (int m = 0; m < 4; ++m) {
                const int row = u.pm * BM + ai * HALF + wr * 64 + m * 16 + fr;
                const float rs = rsqrtf(sumsq[row] * (1.0f / DM) + NORM_EPS);
#pragma unroll
                for (int bj = 0; bj < 2; ++bj) {
                    const int ch0 = u.pn * BM + bj * HALF + wc * 32 + 8 * fq;
                    const h8 v = pack8(acc[ai][bj][m][0] * rs, acc[ai][bj][m][1] * rs);
                    if (ch0 < 1024) { const int g = ch0 >> 4, c0 = ch0 & 15;
                        *(h8*)(UH + ((size_t)g * ROWS_G + (row >> 4)) * UHK + (row & 15) * 16 + c0) = v; }
                    else *(h8*)(gate + (size_t)row * DM + (ch0 - 1024)) = v;
                }
            }
    }
};
struct EpiS1 {
    float* Gp;
    __device__ __forceinline__ void operator()(const f32x4 (&acc)[2][2][4][2], const GUnit& u, int wr, int wc, int fr, int fq) const {
#pragma unroll
        for (int ai = 0; ai < 2; ++ai)
#pragma unroll
            for (int m = 0; m < 4; ++m) {
                const int row = u.pm * BM + ai * HALF + wr * 64 + m * 16 + fr;
                float* p = Gp + ((size_t)u.g * ROWS_G + row) * 128 + wc * 32 + 8 * fq;
                *(f32x4*)p = acc[ai][0][m][0]; *(f32x4*)(p + 4) = acc[ai][0][m][1];
            }
    }
};
struct EpiS3 {
    const float* stepv; h16* Zg;
    static __device__ __forceinline__ float gelu1(float a) { return a * __builtin_amdgcn_rcpf(1.0f + __expf(-1.5957691216f * (a + 0.044715f * a * a * a))); }
    __device__ __forceinline__ void operator()(const f32x4 (&acc)[2][2][4][2], const GUnit& u, int wr, int wc, int fr, int fq) const {
        const float st = stepv[u.g];
        h16* base = Zg + (size_t)u.g * M_TOK * 16 + (size_t)(u.pm * BM + wr * 64 + fr) * 256 + wc * 32 + 8 * fq;
#pragma unroll
        for (int ai = 0; ai < 2; ++ai)
#pragma unroll
            for (int m = 0; m < 4; ++m) {
#pragma unroll
                for (int bj = 0; bj < 2; ++bj) {
                    const f32x4 y0 = acc[ai][bj][m][0] * st, y1 = acc[ai][bj][m][1] * st;
                    h8 o;
#pragma unroll
                    for (int j = 0; j < 4; ++j) { o[j] = (h16)gelu1(y0[j]); o[4 + j] = (h16)gelu1(y1[j]); }
                    *(h8*)(base + (size_t)(ai * HALF + m * 16) * 256 + bj * HALF) = o;
                    __builtin_amdgcn_sched_barrier(0);
                }
            }
    }
};
struct EpiGlu {
    const h16* Zg; const h16* gate; const float* bias; h16* og;
    __device__ __forceinline__ void operator()(const f32x4 (&acc)[2][2][4][2], const GUnit& u, int wr, int wc, int fr, int fq) const {
        const int rowb = u.pm * BM + wr * 64 + fr, nb = u.pn * BM + wc * 32 + 8 * fq;
        h8 zb[3], gb[3];
#define GLU_ISSUE(gi) do { const int bj_ = (gi) >> 3, ai_ = ((gi) >> 2) & 1, m_ = (gi) & 3, n0_ = nb + bj_ * HALF, row_ = rowb + ai_ * HALF + m_ * 16; \
            zb[(gi) % 3] = *(const h8*)(Zg + ((size_t)(n0_ >> 4) * M_TOK + row_) * 16 + (n0_ & 15)); gb[(gi) % 3] = *(const h8*)(gate + (size_t)row_ * DM + n0_); } while (0)
        GLU_ISSUE(0); GLU_ISSUE(1);
        f32x4 b0, b1;
#pragma unroll
        for (int gi = 0; gi < 16; ++gi) {
            if (gi + 2 < 16) GLU_ISSUE(gi + 2);
            const int bj = gi >> 3, ai = (gi >> 2) & 1, m = gi & 3, n0 = nb + bj * HALF, row = rowb + ai * HALF + m * 16;
            if ((gi & 7) == 0) { b0 = *(const f32x4*)(bias + n0); b1 = *(const f32x4*)(bias + n0 + 4); }
            const h8 z = zb[gi % 3], gt = gb[gi % 3];
            const f32x4 a0 = acc[ai][bj][m][0] + b0, a1 = acc[ai][bj][m][1] + b1;
            h8 o;
#pragma unroll
            for (int j = 0; j < 4; ++j) {
                const float g0 = (float)gt[j], g1 = (float)gt[4 + j];
                o[j] = (h16)((float)z[j] * g0 * __builtin_amdgcn_rcpf((1.0f + __expf(-a0[j])) * (1.0f + __expf(-g0))));
                o[4 + j] = (h16)((float)z[4 + j] * g1 * __builtin_amdgcn_rcpf((1.0f + __expf(-a1[j])) * (1.0f + __expf(-g1))));
            }
            *(h8*)(og + (size_t)row * DM + n0) = o;
            __builtin_amdgcn_sched_barrier(0);
        }
#undef GLU_ISSUE
    }
};
struct EpiOut {
    h16* xh; float* sumsq;
    __device__ __forceinline__ void operator()(const f32x4 (&acc)[2][2][4][2], const GUnit& u, int wr, int wc, int fr, int fq) const {
        const int rowb = u.pm * BM + wr * 64 + fr, nb = u.pn * BM + wc * 32 + 8 * fq;
        h8 xb[8][2];
#define OUT_ISSUE(gi) do { _Pragma("unroll") for (int bj = 0; bj < 2; ++bj) xb[gi][bj] = *(const h8*)(xh + (size_t)(rowb + ((gi) >> 2) * HALF + ((gi) & 3) * 16) * DM + nb + bj * HALF); } while (0)
#pragma unroll
        for (int gi = 0; gi < 5; ++gi) OUT_ISSUE(gi);
#pragma unroll
        for (int gi = 0; gi < 8; ++gi) {
            if (gi + 5 < 8) OUT_ISSUE(gi + 5);
            const int ai = gi >> 2, m = gi & 3, row = rowb + ai * HALF + m * 16;
            float ss = 0.f;
#pragma unroll
            for (int bj = 0; bj < 2; ++bj) {
                const h8 xo = xb[gi][bj];
                f32x4 v0, v1;
#pragma unroll
                for (int j = 0; j < 4; ++j) { v0[j] = (float)xo[j] + acc[ai][bj][m][0][j]; v1[j] = (float)xo[4 + j] + acc[ai][bj][m][1][j]; }
                const h8 xn = pack8(v0, v1); *(h8*)(xh + (size_t)row * DM + nb + bj * HALF) = xn;
#pragma unroll
                for (int j = 0; j < 4; ++j) { const float a = (float)xn[j], b = (float)xn[4 + j]; ss += a * a + b * b; }
            }
            ss += __shfl_xor(ss, 16); ss += __shfl_xor(ss, 32);
            if (fq == 0) atomicAdd(sumsq + row, ss);
            __builtin_amdgcn_sched_barrier(0);
        }
#undef OUT_ISSUE
    }
};
struct EpiOutFinal {
    const h16* xh; float* out; float* sumsq; unsigned* cnt; const float* gfin;
    __device__ __forceinline__ void operator()(f32x4 (&acc)[2][2][4][2], const GUnit& u, int wr, int wc, int fr, int fq) const {
        const int rowb = u.pm * BM + wr * 64 + fr, nb = u.pn * BM + wc * 32 + 8 * fq;
        float dummy = 0.f;
#pragma unroll
        for (int ai = 0; ai < 2; ++ai)
#pragma unroll
            for (int m = 0; m < 4; ++m) {
                const int row = rowb + ai * HALF + m * 16;
                float ss = 0.f;
#pragma unroll
                for (int bj = 0; bj < 2; ++bj) {
                    const h8 xo = *(const h8*)(xh + (size_t)row * DM + nb + bj * HALF);
#pragma unroll
                    for (int j = 0; j < 4; ++j) { const float a = (float)xo[j] + acc[ai][bj][m][0][j], b = (float)xo[4 + j] + acc[ai][bj][m][1][j]; acc[ai][bj][m][0][j] = a; acc[ai][bj][m][1][j] = b; ss += a * a + b * b; }
                }
                ss += __shfl_xor(ss, 16); ss += __shfl_xor(ss, 32);
                if (fq == 0) dummy += atomicAdd(sumsq + row, ss);
            }
        asm volatile("s_waitcnt vmcnt(0)" :: "v"(dummy) : "memory");
        if (fr == 0 && fq == 0) __hip_atomic_fetch_add(cnt + u.pm, 1u, __ATOMIC_RELAXED, __HIP_MEMORY_SCOPE_AGENT);
        if (wr == 0 && wc == 0) { while (__hip_atomic_load(cnt + u.pm, __ATOMIC_RELAXED, __HIP_MEMORY_SCOPE_AGENT) < 32u) __builtin_amdgcn_s_sleep(1); }
        __builtin_amdgcn_s_barrier();
        f32x4 g[2][2];
#pragma unroll
        for (int bj = 0; bj < 2; ++bj) { g[bj][0] = *(const f32x4*)(gfin + nb + bj * HALF); g[bj][1] = *(const f32x4*)(gfin + nb + bj * HALF + 4); }
#pragma unroll
        for (int ai = 0; ai < 2; ++ai)
#pragma unroll
            for (int m = 0; m < 4; ++m) {
                const int row = rowb + ai * HALF + m * 16;
                const float rs = rsqrtf(__hip_atomic_load(sumsq + row, __ATOMIC_RELAXED, __HIP_MEMORY_SCOPE_AGENT) * (1.0f / DM) + NORM_EPS);
#pragma unroll
                for (int bj = 0; bj < 2; ++bj) { float* o = out + (size_t)row * DM + nb + bj * HALF;
                    *(f32x4*)o = acc[ai][bj][m][0] * rs * g[bj][0]; *(f32x4*)(o + 4) = acc[ai][bj][m][1] * rs * g[bj][1]; }
            }
    }
};
struct EpiOutLast {
    const h16* xh; float* out; float* sumsq;
    __device__ __forceinline__ void operator()(const f32x4 (&acc)[2][2][4][2], const GUnit& u, int wr, int wc, int fr, int fq) const {
        const int rowb = u.pm * BM + wr * 64 + fr, nb = u.pn * BM + wc * 32 + 8 * fq;
#pragma unroll
        for (int ai = 0; ai < 2; ++ai)
#pragma unroll
            for (int m = 0; m < 4; ++m) {
                const int row = rowb + ai * HALF + m * 16;
                float ss = 0.f;
#pragma unroll
                for (int bj = 0; bj < 2; ++bj) {
                    const size_t off = (size_t)row * DM + nb + bj * HALF;
                    const h8 xo = *(const h8*)(xh + off); f32x4 v0, v1;
#pragma unroll
                    for (int j = 0; j < 4; ++j) { v0[j] = (float)xo[j] + acc[ai][bj][m][0][j]; v1[j] = (float)xo[4 + j] + acc[ai][bj][m][1][j]; ss += v0[j] * v0[j] + v1[j] * v1[j]; }
                    *(f32x4*)(out + off) = v0; *(f32x4*)(out + off + 4) = v1;
                }
                ss += __shfl_xor(ss, 16); ss += __shfl_xor(ss, 32);
                if (fq == 0) atomicAdd(sumsq + row, ss);
            }
    }
};
struct EpiG1Att {
    const float* sumsq; const f32x2* rope; h16* q; h16* k; h16* vt; h16* gate;
    __device__ __forceinline__ void operator()(const f32x4 (&acc)[2][2][4][2], const GUnit& u, int wr, int wc, int fr, int fq) const {
#pragma unroll
        for (int ai = 0; ai < 2; ++ai)
#pragma unroll
            for (int m = 0; m < 4; ++m) {
                const int row = u.pm * BM + ai * HALF + wr * 64 + m * 16 + fr;
                const int l = row & (SEQ - 1);
                const float rs = rsqrtf(sumsq[row] * (1.0f / DM) + NORM_EPS);
#pragma unroll
                for (int bj = 0; bj < 2; ++bj) {
                    const int ct = bj * HALF + wc * 32 + 8 * fq;
                    f32x4 v0 = acc[ai][bj][m][0] * rs, v1 = acc[ai][bj][m][1] * rs;
                    if (u.pn < 4 || (u.pn == 4 && bj == 0)) {
                        const int i0 = (ct & 63) >> 1;
                        const f32x2 cs0 = rope[l * 32 + i0], cs1 = rope[l * 32 + i0 + 1], cs2 = rope[l * 32 + i0 + 2], cs3 = rope[l * 32 + i0 + 3];
                        const float sc = (u.pn < 4) ? 0.125f * LOG2E : 1.0f;
                        f32x4 r0, r1;
                        r0[0] = (v0[0] * cs0.x - v0[1] * cs0.y) * sc; r0[1] = (v0[1] * cs0.x + v0[0] * cs0.y) * sc;
                        r0[2] = (v0[2] * cs1.x - v0[3] * cs1.y) * sc; r0[3] = (v0[3] * cs1.x + v0[2] * cs1.y) * sc;
                        r1[0] = (v1[0] * cs2.x - v1[1] * cs2.y) * sc; r1[1] = (v1[1] * cs2.x + v1[0] * cs2.y) * sc;
                        r1[2] = (v1[2] * cs3.x - v1[3] * cs3.y) * sc; r1[3] = (v1[3] * cs3.x + v1[2] * cs3.y) * sc;
                        const h8 o = pack8(r0, r1);
                        if (u.pn < 4) *(h8*)(q + (size_t)row * DM + u.pn * BM + ct) = o;
                        else *(h8*)(k + (size_t)row * 128 + ct) = o;
                    } else if (u.pn == 4) {
                        *(h8*)(vt + (size_t)row * 128 + (ct - 128)) = pack8(v0, v1);
                    } else {
                        *(h8*)(gate + (size_t)row * DM + (u.pn - 5) * BM + ct) = pack8(v0, v1);
                    }
                }
            }
    }
};

__device__ __forceinline__ float wave_sum(float v) {
#pragma unroll
    for (int o = 1; o < 64; o <<= 1) v += __shfl_xor(v, o);
    return v;
}
template <int MODE>
__device__ __forceinline__ void transpose_item(const float* W, int K, int N, h16* WT, const float* gsc, LAS float* scr, int item, int lane) {
    const int nblk = N / 32, kb = item / nblk, nb = item % nblk, k0 = 64 * kb, n0 = 32 * nb;
    const int nd = n0 + (lane & 31); int src = nd;
    if (MODE == 1 && nd < 1152) { const int j = nd & 63; src = (nd & ~63) + (j >> 1) + 32 * (j & 1); }
    float wv[32];
#pragma unroll
    for (int i = 0; i < 32; ++i) wv[i] = W[(size_t)(k0 + 2 * i + (lane >> 5)) * N + src];
#pragma unroll
    for (int i = 0; i < 32; ++i) { const int kk = 2 * i + (lane >> 5); float v = wv[i]; if (gsc) v *= gsc[k0 + kk]; scr[kk * 33 + (lane & 31)] = v; }
    asm volatile("s_waitcnt lgkmcnt(0)" ::: "memory");
    const int c = lane & 7;
#pragma unroll
    for (int j = 0; j < 4; ++j) { const int n = (lane >> 3) + 8 * j; const LAS float* s = scr + (8 * c) * 33 + n;
        h8 o; o[0] = (h16)s[0 * 33]; o[1] = (h16)s[1 * 33]; o[2] = (h16)s[2 * 33]; o[3] = (h16)s[3 * 33]; o[4] = (h16)s[4 * 33]; o[5] = (h16)s[5 * 33]; o[6] = (h16)s[6 * 33]; o[7] = (h16)s[7 * 33];
        *(h8*)(WT + (size_t)(n0 + n) * K + k0 + 8 * c) = o; }
    asm volatile("s_waitcnt lgkmcnt(0)" ::: "memory");
}

__device__ __forceinline__ void ssm_prep_item(const PV& P, int L, int g, LAS unsigned char* lds, const int tid) {
    const int base = (L == 0) ? 1 : 18;
    const float* a_re = P.in(base + 2) + g * 64; const float* a_im = P.in(base + 3) + g * 64; const float* log_step = P.in(base + 4);
    const float* b_re = P.in(base + 5) + g * 1024; const float* b_im = P.in(base + 6) + g * 1024;
    const float* c_re = P.in(base + 7) + g * 1024; const float* c_im = P.in(base + 8) + g * 1024;
    const float* dsk = P.in(base + 9) + g * 16;
    LAS float* apr = (LAS float*)lds;
    LAS float* api = apr + 64 * 17;
    LAS float* bbr = api + 64 * 17;
    LAS float* bbi = bbr + 1024;
    LAS float* km = bbi + 1024;
    LAS float* crs = km + 4096;
    LAS float* cis = crs + 1024;
    LAS float* cof = cis + 1024;
    const double step = exp((double)log_step[g]);
    for (int e = tid; e < 1024; e += 512) { crs[e] = c_re[e]; cis[e] = c_im[e]; }
    for (int e = tid; e < 64 * 17; e += 512) { const int p = e / 17, k = e % 17; const double mag = exp((double)k * step * (double)a_re[p]), ang = (double)k * step * (double)a_im[p];
        apr[e] = (float)(mag * cos(ang)); api[e] = (float)(mag * sin(ang)); }
    if (tid < 64) { const int p = tid; const double lr = a_re[p], li = a_im[p]; const double mag = exp(step * lr), ang = step * li;
        const double er = mag * cos(ang) - 1.0, ei = mag * sin(ang); const double den = (lr * lr + li * li) * step;
        cof[2 * p] = (float)((er * lr + ei * li) / den); cof[2 * p + 1] = (float)((ei * lr - er * li) / den); }
    __syncthreads();
    for (int e = tid; e < 1024; e += 512) { const int p = e >> 4; const float cr = cof[2 * p], ci = cof[2 * p + 1]; const float br = b_re[e], bi = b_im[e];
        bbr[e] = cr * br - ci * bi; bbi[e] = cr * bi + ci * br; }
    __syncthreads();
    for (int e = tid; e < 4096; e += 512) { const int lag = e >> 8, c = (e >> 4) & 15, cp = e & 15; float s = 0.f;
        for (int p = 0; p < 64; ++p) { const float ar = apr[p * 17 + lag], ai = api[p * 17 + lag], br = bbr[p * 16 + cp], bi = bbi[p * 16 + cp];
            const float wr_ = ar * br - ai * bi, wi_ = ar * bi + ai * br; s += crs[c * 64 + p] * wr_ - cis[c * 64 + p] * wi_; }
        km[e] = s; }
    __syncthreads();
    h16* bt3 = (h16*)(P.ws() + WS_BT3) + (size_t)(L * 64 + g) * 256 * 384;
    const float inv_step = (float)(1.0 / step);
    for (int e = tid; e < 256 * 384; e += 512) { const int n = e / 384, k = e % 384, t = n >> 4, c = n & 15; float v;
        if (k < 256) { const int s = k >> 4, cp = k & 15; v = (s <= t) ? km[((t - s) << 8) + (c << 4) + cp] : 0.f; if (s == t && c == cp) v += dsk[c] * inv_step; }
        else { const int kk = k - 256, p = kk & 63; const float ar = apr[p * 17 + t + 1], ai = api[p * 17 + t + 1], cr = crs[c * 64 + p], ci = cis[c * 64 + p];
            v = (kk < 64) ? (cr * ar - ci * ai) : -(cr * ai + ci * ar); }
        bt3[e] = (h16)v; }
    h16* bt1 = (h16*)(P.ws() + WS_BT1) + (size_t)(L * 64 + g) * 256 * 256;
    for (int e = tid; e < 65536; e += 512) { const int n = e >> 8, k = e & 255, s = k >> 4, c = k & 15; float v = 0.f;
        if (n < 128) { const int p = n & 63; const float ar = apr[p * 17 + 15 - s], ai = api[p * 17 + 15 - s], br = bbr[p * 16 + c], bi = bbi[p * 16 + c];
            v = (n < 64) ? (ar * br - ai * bi) : (ar * bi + ai * br); }
        bt1[e] = (h16)v; }
    if (tid < 64) { const int p = tid; f32x2* a16 = (f32x2*)(P.ws() + WS_A16) + (L * 64 + g) * 64; f32x2* asg = (f32x2*)(P.ws() + WS_ASEG) + (L * 64 + g) * 64;
        a16[p] = (f32x2){apr[p * 17 + 16], api[p * 17 + 16]};
        const double mag = exp(2048.0 * step * (double)a_re[p]), ang = 2048.0 * step * (double)a_im[p]; asg[p] = (f32x2){(float)(mag * cos(ang)), (float)(mag * sin(ang))}; }
    if (tid == 0) ((float*)(P.ws() + WS_STEP))[L * 64 + g] = (float)step;
    __syncthreads();
}

__device__ __forceinline__ void prep_phase(const PV& P, LAS unsigned char* lds, const int wave_s) {
    const int tid = get_tid(wave_s);
    const int lane = tid & 63, wave = tid >> 6, G = gridDim.x;
    const bool split = (G == 256);
    const bool builder = true;
    const int GB = G;
    const int gw = blockIdx.x * 8 + wave, NGW = GB * 8;
    unsigned char* ws = P.ws();
    if (builder) {
    for (int it = blockIdx.x; it < 128; it += GB) ssm_prep_item(P, it >> 6, it & 63, lds, tid);
    __syncthreads();
    { float* ss = (float*)(P.ws() + WS_SUMSQ) + M_TOK; for (size_t i = (size_t)blockIdx.x * 512 + tid; i < (size_t)4 * M_TOK; i += (size_t)GB * 512) ss[i] = 0.f; }
    if (blockIdx.x == 0) { if (tid < 256) ((unsigned*)(P.ws() + WS_CNT))[tid] = 0u; for (int i = tid; i < XCD_BAR_WORDS; i += 512) ((unsigned*)(P.ws() + WS_BAR))[i] = 0u; }
    { f32x2* rope = (f32x2*)(P.ws() + WS_ROPE);
      const float inv = (float)exp2(-(double)(2 * (tid & 31)) / 64.0 * 13.287712379549449);
      for (int e = blockIdx.x * 512 + tid; e < SEQ * 32; e += GB * 512) { const int l = e >> 5; const float ang = (float)l * inv;
          rope[e] = (f32x2){(float)cos((double)ang), (float)sin((double)ang)}; } }
    LAS float* scr = (LAS float*)(lds + wave * 8704);
    constexpr int I_IN_S = 16 * 64, I_SQ = 16 * 32, I_IN_A = 16 * 72;
    constexpr int NITEMS = 2 * (I_IN_S + 2 * I_SQ) + 2 * (I_IN_A + I_SQ);
    for (int it = gw; it < NITEMS; it += NGW) {
        int r = it;
        if (r < I_IN_S) { transpose_item<0>(P.in(2), 1024, 2048, (h16*)(ws + W_IN0), P.in(1), scr, r, lane); continue; } r -= I_IN_S;
        if (r < I_SQ) { transpose_item<0>(P.in(11), 1024, 1024, (h16*)(ws + W_GLU0), nullptr, scr, r, lane); continue; } r -= I_SQ;
        if (r < I_SQ) { transpose_item<0>(P.in(13), 1024, 1024, (h16*)(ws + W_OUT0), nullptr, scr, r, lane); continue; } r -= I_SQ;
        if (r < I_IN_A) { transpose_item<1>(P.in(15), 1024, 2304, (h16*)(ws + W_IN1), P.in(14), scr, r, lane); continue; } r -= I_IN_A;
        if (r < I_SQ) { transpose_item<0>(P.in(17), 1024, 1024, (h16*)(ws + W_OUT1), nullptr, scr, r, lane); continue; } r -= I_SQ;
        if (r < I_IN_S) { transpose_item<0>(P.in(19), 1024, 2048, (h16*)(ws + W_IN2), P.in(18), scr, r, lane); continue; } r -= I_IN_S;
        if (r < I_SQ) { transpose_item<0>(P.in(28), 1024, 1024, (h16*)(ws + W_GLU2), nullptr, scr, r, lane); continue; } r -= I_SQ;
        if (r < I_SQ) { transpose_item<0>(P.in(30), 1024, 1024, (h16*)(ws + W_OUT2), nullptr, scr, r, lane); continue; } r -= I_SQ;
        if (r < I_IN_A) { transpose_item<1>(P.in(32), 1024, 2304, (h16*)(ws + W_IN3), P.in(31), scr, r, lane); continue; } r -= I_IN_A;
        transpose_item<0>(P.in(34), 1024, 1024, (h16*)(ws + W_OUT3), nullptr, scr, r, lane);
    }
    }
    { const float* x = P.in(0); h16* xh = (h16*)(ws + WS_XH); float* ss0 = (float*)(ws + WS_SUMSQ);
      int row0, nrows, stride;
      if (split) { if (blockIdx.x < 128) { row0 = gw * 24; nrows = 24; } else { row0 = 24576 + (gw - 1024) * 40; nrows = 40; } stride = 0; }
      else { row0 = gw * 4; nrows = M_TOK; stride = NGW * 4; }
      for (int r = 0; ; r += 4) {
          int row;
          if (stride == 0) { if (r >= nrows) break; row = row0 + r; } else { row = row0 + (r >> 2) * stride; if (row >= M_TOK) break; }
          f32x4 v[4][4];
#pragma unroll
          for (int q = 0; q < 4; ++q)
#pragma unroll
              for (int j = 0; j < 4; ++j) v[q][j] = ((const f32x4*)(x + (size_t)(row + q) * DM) + lane)[64 * j];
#pragma unroll
          for (int q = 0; q < 4; ++q) { h4* o = (h4*)(xh + (size_t)(row + q) * DM) + lane; float sq = 0.f;
#pragma unroll
              for (int j = 0; j < 4; ++j) { const f32x4 t = v[q][j]; sq += (t[0] * t[0] + t[1] * t[1]) + (t[2] * t[2] + t[3] * t[3]); h4 hv; hv[0] = (h16)t[0]; hv[1] = (h16)t[1]; hv[2] = (h16)t[2]; hv[3] = (h16)t[3]; o[64 * j] = hv; }
              sq = wave_sum(sq); if (lane == 0) ss0[row + q] = sq; }
      } }
}

__device__ __forceinline__ void s2_phase(const PV& P, int L, LAS unsigned char* lds, const int wave_s) {
    const int tid = get_tid(wave_s);
    const int lane = tid & 63, wave = tid >> 6, seg = wave & 3;
    LAS f32x2* E = (LAS f32x2*)lds;
    for (int gb0 = blockIdx.x * 2; gb0 < 512; gb0 += gridDim.x * 2) {
        const int gb = gb0 + (wave >> 2), g = gb >> 3, b = gb & 7;
        const f32x2 a = ((const f32x2*)(P.ws() + WS_A16))[(L * 64 + g) * 64 + lane];
        const f32x2 as = ((const f32x2*)(P.ws() + WS_ASEG))[(L * 64 + g) * 64 + lane];
        const float* Gp = (const float*)(P.ws() + WS_GP) + ((size_t)g * ROWS_G + b * 512 + seg * 128) * 128 + lane;
        float hr = 0.f, hi = 0.f;
        for (int n = 0; n < 128; n += 16) {
            float gr[16], gi[16];
#pragma unroll
            for (int j = 0; j < 16; ++j) { gr[j] = Gp[(size_t)(n + j) * 128]; gi[j] = Gp[(size_t)(n + j) * 128 + 64]; }
#pragma unroll
            for (int j = 0; j < 16; ++j) { const float t = a.x * hr - a.y * hi + gr[j]; hi = a.x * hi + a.y * hr + gi[j]; hr = t; }
        }
        E[wave * 64 + lane] = (f32x2){hr, hi};
        __syncthreads();
        float sr = 0.f, si = 0.f;
        for (int i = 0; i < seg; ++i) { const f32x2 e = E[((wave & ~3) + i) * 64 + lane]; const float t = as.x * sr - as.y * si + e.x; si = as.x * si + as.y * sr + e.y; sr = t; }
        h16* H = (h16*)(P.ws() + WS_UH) + ((size_t)g * ROWS_G + b * 512 + seg * 128) * UHK + 256 + lane;
        hr = sr; hi = si;
        for (int n = 0; n < 128; n += 16) {
            float gr[16], gi[16];
#pragma unroll
            for (int j = 0; j < 16; ++j) { gr[j] = Gp[(size_t)(n + j) * 128]; gi[j] = Gp[(size_t)(n + j) * 128 + 64]; }
#pragma unroll
            for (int j = 0; j < 16; ++j) { H[(size_t)(n + j) * UHK] = (h16)hr; H[(size_t)(n + j) * UHK + 64] = (h16)hi;
                const float t = a.x * hr - a.y * hi + gr[j]; hi = a.x * hi + a.y * hr + gi[j]; hr = t; }
        }
        __syncthreads();
    }
}

__device__ __forceinline__ int crow(int r, int hi) { return (r & 3) + 8 * (r >> 2) + 4 * hi; }
__device__ __forceinline__ void attn_phase(const PV& P, int layer, LAS unsigned char* lds, const int wave_s) {
    const h16* q = (const h16*)(P.ws() + WS_UH); const h16* k = (const h16*)(P.ws() + WS_K); const h16* vt = (const h16*)(P.ws() + WS_VT);
    const h16* gate = (const h16*)(P.ws() + WS_GATE); h16* og = (h16*)(P.ws() + WS_OG);
    const float* sinks = P.in(layer == 1 ? 16 : 33);
    const int tid = get_tid(wave_s);
    const int lane = tid & 63, wave = __builtin_amdgcn_readfirstlane(tid >> 6), l31 = lane & 31, hi = lane >> 5;
    LAS h16* Ks = (LAS h16*)lds;
    LAS h16* Vs = (LAS h16*)(lds + 36864);
    LAS h16* Os = (LAS h16*)(lds + 70144) + wave * (32 * 72);
    const int G = gridDim.x;
    int unit = blockIdx.x;
    if (unit >= 1024) return;
    unsigned m0 = 0;
#pragma unroll
    for (int r = 0; r < 16; ++r) if (crow(r, hi) > l31) m0 |= 1u << r;
    const int grow = lane >> 3, gcol = (lane & 7) * 8;
    h8 kvr[8];
#define ATT_LOADKV(U) do { const int kvh_ = (U) & 1, blk_ = ((U) >> 1) & 63, b_ = (U) >> 7; \
        _Pragma("unroll") for (int c_ = 0; c_ < 4; ++c_) { const int id = tid + 512 * c_, key = id >> 3, part = id & 7; const int l = blk_ * 128 - 128 + key; \
            kvr[c_] = (h8)(h16)0.f; if (l >= 0) kvr[c_] = *(const h8*)(k + ((size_t)b_ * SEQ + l) * 128 + kvh_ * 64 + part * 8); } \
        _Pragma("unroll") for (int c_ = 0; c_ < 4; ++c_) { const int id = tid + 512 * c_, key = id & 255, part = id >> 8; const int l = blk_ * 128 - 128 + key; \
            kvr[4 + c_] = (h8)(h16)0.f; if (l >= 0) kvr[4 + c_] = *(const h8*)(vt + ((size_t)b_ * SEQ + l) * 128 + kvh_ * 64 + part * 8); } } while (0)
#define ATT_STOREKV() do { \
        _Pragma("unroll") for (int c_ = 0; c_ < 4; ++c_) { const int id = tid + 512 * c_, key = id >> 3, part = id & 7; *(LAS h8*)(Ks + key * 72 + part * 8) = kvr[c_]; } \
        _Pragma("unroll") for (int c_ = 0; c_ < 4; ++c_) { const int id = tid + 512 * c_, key = id & 255, part = id >> 8; LAS h16* dst = Vs + (part * 8) * 260 + key; \
            _Pragma("unroll") for (int j_ = 0; j_ < 8; ++j_) dst[j_ * 260] = kvr[4 + c_][j_]; } } while (0)
#define ATT_LOADQ(U, I) do { const int kvh_ = (U) & 1, blk_ = ((U) >> 1) & 63, b_ = (U) >> 7; const h16* qp = q + ((size_t)b_ * SEQ + blk_ * 128 + 32 * (I) + l31) * DM + (kvh_ * 8 + wave) * 64 + 8 * hi; \
        _Pragma("unroll") for (int ds = 0; ds < 4; ++ds) qf[ds] = *(const h8*)(qp + 16 * ds); } while (0)
    h8 qf[4];
    ATT_LOADKV(unit);
    ATT_LOADQ(unit, 0);
    ATT_STOREKV();
    __syncthreads();
    for (;;) {
        const int kvh = unit & 1, blk = (unit >> 1) & 63, b = unit >> 7, hq = kvh * 8 + wave;
        const float sink2 = sinks[hq] * LOG2E;
        const int nunit = unit + G; const bool has_next = nunit < 1024;
#pragma unroll
        for (int i = 0; i < 4; ++i) {
            const size_t tok0 = (size_t)b * SEQ + blk * 128 + 32 * i;
            if (i == 3 && has_next) ATT_LOADKV(nunit);
            f32x16 s[5];
#pragma unroll
            for (int t5 = 0; t5 < 5; ++t5) { f32x16 a16;
#pragma unroll
                for (int r = 0; r < 16; ++r) a16[r] = 0.f;
#pragma unroll
                for (int ds = 0; ds < 4; ++ds) { const h8 kf = *(const LAS h8*)(Ks + (32 * (i + t5) + l31) * 72 + 16 * ds + 8 * hi); a16 = __builtin_amdgcn_mfma_f32_32x32x16_f16(kf, qf[ds], a16, 0, 0, 0); }
                s[t5] = a16; }
            h8 gt[4];
#pragma unroll
            for (int j = 0; j < 4; ++j) gt[j] = *(const h8*)(gate + (tok0 + grow + 8 * j) * DM + hq * 64 + gcol);
#pragma unroll
            for (int r = 0; r < 16; ++r) { const bool in0 = (m0 >> r) & 1u; s[0][r] = in0 ? s[0][r] : -1e30f; s[4][r] = in0 ? -1e30f : s[4][r]; }
            if (blk == 0) {
#pragma unroll
                for (int t5 = 0; t5 < 4; ++t5) if (i + t5 < 4) {
#pragma unroll
                    for (int r = 0; r < 16; ++r) s[t5][r] = -1e30f; }
            }
            float mx = sink2;
#pragma unroll
            for (int t5 = 0; t5 < 5; ++t5)
#pragma unroll
                for (int r = 0; r < 16; ++r) mx = fmaxf(mx, s[t5][r]);
            mx = fmaxf(mx, __shfl_xor(mx, 32));
            float sum = 0.f;
#pragma unroll
            for (int t5 = 0; t5 < 5; ++t5)
#pragma unroll
                for (int r = 0; r < 16; ++r) { const float p = __builtin_amdgcn_exp2f(s[t5][r] - mx); s[t5][r] = p; sum += p; }
            sum += __shfl_xor(sum, 32);
            sum += __builtin_amdgcn_exp2f(sink2 - mx);
            const float inv = __builtin_amdgcn_rcpf(sum);
            f32x16 o0, o1;
#pragma unroll
            for (int r = 0; r < 16; ++r) { o0[r] = 0.f; o1[r] = 0.f; }
#pragma unroll
            for (int t5 = 0; t5 < 5; ++t5)
#pragma unroll
                for (int ss = 0; ss < 2; ++ss) { h8 pf;
#pragma unroll
                    for (int j = 0; j < 8; ++j) pf[j] = (h16)(s[t5][8 * ss + j] * inv);
                    const int kb = 32 * (i + t5) + 16 * ss + 4 * hi;
                    { const LAS h16* vp = Vs + l31 * 260 + kb; const h4 lo = *(const LAS h4*)vp, hi4 = *(const LAS h4*)(vp + 8);
                      const h8 vf = __builtin_shufflevector(lo, hi4, 0, 1, 2, 3, 4, 5, 6, 7); o0 = __builtin_amdgcn_mfma_f32_32x32x16_f16(pf, vf, o0, 0, 0, 0); }
                    { const LAS h16* vp = Vs + (32 + l31) * 260 + kb; const h4 lo = *(const LAS h4*)vp, hi4 = *(const LAS h4*)(vp + 8);
                      const h8 vf = __builtin_shufflevector(lo, hi4, 0, 1, 2, 3, 4, 5, 6, 7); o1 = __builtin_amdgcn_mfma_f32_32x32x16_f16(pf, vf, o1, 0, 0, 0); } }
            if (i < 3) ATT_LOADQ(unit, i + 1); else if (has_next) ATT_LOADQ(nunit, 0);
#pragma unroll
            for (int r = 0; r < 16; ++r) { LAS h16* op = Os + crow(r, hi) * 72 + l31; op[0] = (h16)o0[r]; op[32] = (h16)o1[r]; }
#pragma unroll
            for (int j = 0; j < 4; ++j) { const h8 ov = *(const LAS h8*)(Os + (grow + 8 * j) * 72 + gcol); h8 res;
#pragma unroll
                for (int e = 0; e < 8; ++e) { const float g = (float)gt[j][e]; res[e] = (h16)((float)ov[e] * g * sigmoidf_(g)); }
                *(h8*)(og + (tok0 + grow + 8 * j) * DM + hq * 64 + gcol) = res; }
        }
        if (!has_next) break;
        __syncthreads();
        ATT_STOREKV();
        __syncthreads();
        unit = nunit;
    }
#undef ATT_LOADKV
#undef ATT_STOREKV
#undef ATT_LOADQ
}

__device__ __forceinline__ void final_norm_phase(const PV& P, const int wave_s) {
    const int tid = get_tid(wave_s);
    const int lane = tid & 63, wave = tid >> 6; const int gw = blockIdx.x * 8 + wave, NGW = gridDim.x * 8;
    const float* ss = (const float*)(P.ws() + WS_SUMSQ) + (size_t)4 * M_TOK; const f32x4* gn = (const f32x4*)P.in(35);
    f32x4 gv[4];
#pragma unroll
    for (int j = 0; j < 4; ++j) gv[j] = gn[64 * j + lane];
    for (int row = gw; row < M_TOK; row += NGW) { const float rs = rsqrtf(ss[row] * (1.0f / DM) + NORM_EPS); f32x4* xr = (f32x4*)(P.out() + (size_t)row * DM) + lane;
#pragma unroll
        for (int j = 0; j < 4; ++j) { const f32x4 v = xr[64 * j]; xr[64 * j] = v * rs * gv[j]; } }
}


#define XB_TMO      128
#define XB_XCNT(j)  (256  + 64 * (j))
#define XB_XSUB(j)  (1280 + 64 * (j))
#define XB_XGEN(j)  (2304 + 64 * (j))
#define XB_TOP      3328
#define XB_TOPGEN   3392
#define XB_SPIN_CAP (1u << 22)
__device__ __forceinline__ unsigned xb_ld(unsigned* p)              { return __hip_atomic_load(p, __ATOMIC_RELAXED, __HIP_MEMORY_SCOPE_AGENT); }
__device__ __forceinline__ unsigned xb_add(unsigned* p, unsigned v) { return __hip_atomic_fetch_add(p, v, __ATOMIC_RELAXED, __HIP_MEMORY_SCOPE_AGENT); }
__device__ __forceinline__ unsigned xb_xcc_id() { return (unsigned)__builtin_amdgcn_s_getreg((3 << 11) | 20) & 0xFu; }
#define XB_SPIN(cond, bar) do { unsigned _sp = 0; while (cond) { __builtin_amdgcn_s_sleep(1); \
    if ((++_sp & 255u) == 0u) { if (xb_ld(&(bar)[XB_TMO])) break; if (_sp > XB_SPIN_CAP) { atomicAdd(&(bar)[XB_TMO], 1u); break; } } } } while (0)
struct XcdBarrier { unsigned* bar; unsigned x; volatile LAS unsigned* st; };
__device__ __forceinline__ XcdBarrier xcd_barrier_post(unsigned* bar, volatile LAS unsigned* st, int tid) {
    XcdBarrier b; b.bar = bar; b.x = xb_xcc_id(); b.st = st;
    if (tid == 0) (void)xb_add(&bar[XB_XCNT(b.x)], 1u);
    return b;
}
__device__ __forceinline__ void xcd_barrier_complete(unsigned* bar, unsigned x, unsigned& nloc, unsigned& nx) {
    const unsigned G = gridDim.x * gridDim.y * gridDim.z;
    unsigned sum, cnt, mine, sp = 0u;
    for (;;) {
        sum = 0u; cnt = 0u; mine = 0u;
#pragma unroll
        for (unsigned j = 0; j < 16; ++j) { const unsigned c = xb_ld(&bar[XB_XCNT(j)]); sum += c; cnt += (c > 0u) ? 1u : 0u; mine = (j == x) ? c : mine; }
        if (sum == G) break;
        __builtin_amdgcn_s_sleep(1);
        if ((++sp & 255u) == 0u) { if (xb_ld(&bar[XB_TMO])) break; if (sp > XB_SPIN_CAP) { atomicAdd(&bar[XB_TMO], 1u); break; } }
    }
    nloc = mine > 0u ? mine : 1u; nx = cnt > 0u ? cnt : 1u;
}
__device__ __forceinline__ void xcd_barrier(const XcdBarrier& b, int wave_s) {
    asm volatile("s_waitcnt vmcnt(0)" ::: "memory");
    __syncthreads();
    if (get_tid(wave_s) == 0) {
        unsigned* bar = b.bar;
        __builtin_amdgcn_s_waitcnt(0);
        unsigned nloc = b.st[0], nx = b.st[1];
        if (nloc == 0u) { xcd_barrier_complete(bar, b.x, nloc, nx); b.st[0] = nloc; b.st[1] = nx; }
        const unsigned old = xb_add(&bar[XB_XSUB(b.x)], 1u);
        const unsigned gen = old / nloc;
        if (old + 1u == (gen + 1u) * nloc) {
            __builtin_amdgcn_fence(__ATOMIC_RELEASE, "agent");
            asm volatile("s_waitcnt vmcnt(0)" ::: "memory");
            const unsigned og = xb_add(&bar[XB_TOP], 1u);
            const unsigned tg = og / nx;
            if (og + 1u == (tg + 1u) * nx) xb_add(&bar[XB_TOPGEN], 1u);
            else XB_SPIN(xb_ld(&bar[XB_TOPGEN]) == tg, bar);
            __builtin_amdgcn_fence(__ATOMIC_ACQUIRE, "agent");
            xb_add(&bar[XB_XGEN(b.x)], 1u);
            asm volatile("s_waitcnt vmcnt(0)" ::: "memory");
        } else {
            XB_SPIN(xb_ld(&bar[XB_XGEN(b.x)]) == gen, bar);
            __builtin_amdgcn_fence(__ATOMIC_ACQUIRE, "agent");
            asm volatile("s_waitcnt vmcnt(0)" ::: "memory");
        }
    }
    __syncthreads();
}

#ifndef PROBE_PHASE
#define PROBE_PHASE -1
#endif
#define PROBE_K 8
#define PB(id) do { if (PROBE_PHASE == (id) && layer < 2) pt0 = __builtin_amdgcn_s_memrealtime(); } while (0)
#define SYNC(id) do { xcd_barrier(bar, wave_s); if (PROBE_PHASE == (id) && layer < 2 && blockIdx.x == 0) { const unsigned long long t1 = __builtin_amdgcn_s_memrealtime(); const unsigned long long dt = (t1 - pt0) * PROBE_K; \
    while (__builtin_amdgcn_s_memrealtime() - t1 < dt) __builtin_amdgcn_s_sleep(8); } } while (0)
constexpr int LDS_BYTES = 135168;
__global__ void __launch_bounds__(512) fwd_megakernel(Params KP) {
    LAS unsigned char* lds = (LAS unsigned char*)lds_raw;
    cg::grid_group grid = cg::this_grid();
    const int wave_s = __builtin_amdgcn_readfirstlane((int)(threadIdx.x >> 6));
    const int G = gridDim.x, c = blockIdx.x;
    volatile LAS unsigned* bst = (volatile LAS unsigned*)(lds + 131072);
    if (threadIdx.x < 2) bst[threadIdx.x] = 0u;
    volatile LAS unsigned long long* ptab = (volatile LAS unsigned long long*)(lds + 131072 + 16);
    if (threadIdx.x == 0) {
#pragma unroll
        for (int i = 0; i < 36; ++i) ptab[i] = (unsigned long long)KP.in[i];
        ptab[36] = (unsigned long long)KP.out; ptab[37] = (unsigned long long)KP.ws;
    }
    __syncthreads();
    const PV P{};
    const AGeo plainA{2048u, 32u, 128};

#ifndef PH_MASK
#define PH_MASK 0xFFFF
#endif
    unsigned long long pt0 = 0;
    if (PROBE_PHASE == 0) pt0 = __builtin_amdgcn_s_memrealtime();
    if (PH_MASK & 1) prep_phase(P, lds, wave_s);
    grid.sync();
    if (PROBE_PHASE == 0 && blockIdx.x == 0) { const unsigned long long t1 = __builtin_amdgcn_s_memrealtime(); const unsigned long long dt = (t1 - pt0) * PROBE_K; while (__builtin_amdgcn_s_memrealtime() - t1 < dt) __builtin_amdgcn_s_sleep(8); }
    const XcdBarrier bar = xcd_barrier_post((unsigned*)(P.ws() + WS_BAR), bst, get_tid(wave_s));

#pragma unroll 1
    for (int layer = 0; layer < 4; ++layer) {
        unsigned char* ws = P.ws();
        float* sumsq = (float*)(ws + WS_SUMSQ);
        h16* xh = (h16*)(ws + WS_XH); h16* UH = (h16*)(ws + WS_UH); float* Gp = (float*)(ws + WS_GP); h16* gate = (h16*)(ws + WS_GATE);
        h16* Zg = (h16*)(ws + WS_ZG); h16* og = (h16*)(ws + WS_OG);
        if ((layer & 1) == 0) {
            const int L = layer >> 1;
            const unsigned char* win = ws + (L ? W_IN2 : W_IN0); const unsigned char* wglu = ws + (L ? W_GLU2 : W_GLU0); const unsigned char* wout = ws + (L ? W_OUT2 : W_OUT0);
            const float* bglu = P.in(L ? 29 : 12);
            { PlainOrder S; S.init(M_TOK, 2048, G, c, xh, (size_t)256 * 2048, win, (size_t)256 * 2048);
              EpiG1Ssm E{sumsq + (size_t)layer * M_TOK, UH, gate};
              PB(1); if (PH_MASK & 2) gemm_phase(lds, wave_s, plainA, 2048u, 16, S, E); }
            SYNC(1);
            { GroupOrder S{G, c, (const char*)UH, (const char*)(ws + WS_BT1) + (size_t)L * 64 * 256 * 256 * 2, (size_t)ROWS_G * UHK * 2, (size_t)256 * 256 * 2, (size_t)256 * UHK * 2};
              EpiS1 E{Gp};
              PB(2); if (PH_MASK & 4) gemm_phase(lds, wave_s, AGeo{UHK * 2u, 32u, 128}, 512u, 4, S, E); }
            SYNC(2);
            PB(3); if (PH_MASK & 8) s2_phase(P, L, lds, wave_s);
            SYNC(3);
            { GroupOrder S{G, c, (const char*)UH, (const char*)(ws + WS_BT3) + (size_t)L * 64 * 256 * 384 * 2, (size_t)ROWS_G * UHK * 2, (size_t)256 * 384 * 2, (size_t)256 * UHK * 2};
              EpiS3 E{(const float*)(ws + WS_STEP) + L * 64, Zg};
              PB(4); if (PH_MASK & 16) gemm_phase(lds, wave_s, AGeo{UHK * 2u, 32u, 128}, 768u, 6, S, E); }
            SYNC(4);
            { PlainOrder S; S.init(M_TOK, 1024, G, c, Zg, (size_t)256 * 32, wglu, (size_t)256 * 2048);
              EpiGlu E{Zg, gate, bglu, og};
              PB(5); if (PH_MASK & 32) gemm_phase(lds, wave_s, AGeo{32u, (unsigned)(M_TOK * 32), (size_t)4 * M_TOK * 32}, 2048u, 16, S, E); }
            SYNC(5);
            { PlainOrder S; S.init(M_TOK, 1024, G, c, og, (size_t)256 * 2048, wout, (size_t)256 * 2048);
              EpiOut E{xh, sumsq + (size_t)(layer + 1) * M_TOK};
              PB(6); if (PH_MASK & 64) gemm_phase(lds, wave_s, plainA, 2048u, 16, S, E); }
            SYNC(6);
        } else {
            const unsigned char* win = ws + (layer == 1 ? W_IN1 : W_IN3); const unsigned char* wout = ws + (layer == 1 ? W_OUT1 : W_OUT3);
            { PlainOrder S; S.init(M_TOK, 2304, G, c, xh, (size_t)256 * 2048, win, (size_t)256 * 2048);
              EpiG1Att E{sumsq + (size_t)layer * M_TOK, (const f32x2*)(ws + WS_ROPE), (h16*)(ws + WS_UH), (h16*)(ws + WS_K), (h16*)(ws + WS_VT), gate};
              PB(7); if (PH_MASK & 128) gemm_phase(lds, wave_s, plainA, 2048u, 16, S, E); }
            SYNC(7);
            PB(8); if (PH_MASK & 256) attn_phase(P, layer, lds, wave_s);
            SYNC(8);
            { PlainOrder S; S.init(M_TOK, 1024, G, c, og, (size_t)256 * 2048, wout, (size_t)256 * 2048);
              if (layer == 1) { EpiOut E{xh, sumsq + (size_t)(layer + 1) * M_TOK};
                PB(9); if (PH_MASK & 512) gemm_phase(lds, wave_s, plainA, 2048u, 16, S, E); }
              else if (G == 256) { EpiOutFinal E{xh, P.out(), sumsq + (size_t)4 * M_TOK, (unsigned*)(ws + WS_CNT), P.in(35)};
                gemm_phase(lds, wave_s, plainA, 2048u, 16, S, E); }
              else { EpiOutLast E{xh, P.out(), sumsq + (size_t)4 * M_TOK};
                gemm_phase(lds, wave_s, plainA, 2048u, 16, S, E); } }
            if (!(layer == 3 && G == 256)) SYNC(9);
        }
    }
    { const int layer = 0; PB(10); if ((PH_MASK & 1024) && G != 256) final_norm_phase(P, wave_s);
      if (PROBE_PHASE == 10 && blockIdx.x == 0) { const unsigned long long t1 = __builtin_amdgcn_s_memrealtime(); const unsigned long long dt = (t1 - pt0) * PROBE_K; while (__builtin_amdgcn_s_memrealtime() - t1 < dt) __builtin_amdgcn_s_sleep(8); } }
}

extern "C" void kernel_launch(void* const* d_in, const int* in_sizes, int n_in, void* d_out, int out_size, void* d_ws, size_t ws_size, hipStream_t stream) {
    static int grid_blocks = 0;
    if (grid_blocks == 0) {
        if (n_in != 36 || ws_size < WS_END) { fprintf(stderr, "kernel_launch: unexpected n_in %d / ws %zu\n", n_in, ws_size); grid_blocks = -1; return; }
        int dev = 0, cus = 0, per_cu = 0;
        hipGetDevice(&dev);
        hipDeviceGetAttribute(&cus, hipDeviceAttributeMultiprocessorCount, dev);
        hipFuncSetAttribute((const void*)fwd_megakernel, hipFuncAttributeMaxDynamicSharedMemorySize, LDS_BYTES);
        hipOccupancyMaxActiveBlocksPerMultiprocessor(&per_cu, (const void*)fwd_megakernel, 512, LDS_BYTES);
        if (per_cu < 1) per_cu = 1;
        grid_blocks = cus * per_cu;
        (void)hipGetLastError();
    }
    if (grid_blocks < 0) return;
    Params p{};
    for (int i = 0; i < 36; ++i) p.in[i] = (const float*)d_in[i];
    p.out = (float*)d_out; p.ws = (unsigned char*)d_ws;
    void* args[] = {&p};
    hipError_t e = hipLaunchCooperativeKernel((const void*)fwd_megakernel, dim3(grid_blocks), dim3(512), args, LDS_BYTES, stream);
    if (e != hipSuccess) fprintf(stderr, "cooperative launch failed: %s (grid %d)\n", hipGetErrorString(e), grid_blocks);
}
```

```cpp
#include <hip/hip_runtime.h>
#include <hip/hip_cooperative_groups.h>
#include <cstdint>
#include <cstdio>
namespace cg = cooperative_groups;

#define LAS __attribute__((address_space(3)))
typedef _Float16 h16;
typedef _Float16 h8 __attribute__((ext_vector_type(8)));
typedef _Float16 h4 __attribute__((ext_vector_type(4)));
typedef float f32x4 __attribute__((ext_vector_type(4)));
typedef float f32x2 __attribute__((ext_vector_type(2)));
typedef float f32x16 __attribute__((ext_vector_type(16)));

__device__ __forceinline__ int get_tid(int wave_s) { int t = wave_s * 64 + (int)__builtin_amdgcn_mbcnt_hi(~0u, __builtin_amdgcn_mbcnt_lo(~0u, 0u)); asm volatile("" : "+v"(t)); return t; }

constexpr int M_TOK = 65536, DM = 1024, SEQ = 8192;
constexpr int ROWS_G = 2048;
constexpr int UHK = 640;
constexpr float NORM_EPS = 1e-5f;
constexpr float LOG2E = 1.4426950408889634f;

constexpr size_t MiB = 1u << 20;
constexpr size_t WS_SUMSQ = 0;
constexpr size_t WS_ROPE  = 2 * MiB;
constexpr size_t WS_A16   = 4 * MiB;
constexpr size_t WS_ASEG  = 4 * MiB + 65536;
constexpr size_t WS_STEP  = 4 * MiB + 131072;
constexpr size_t WS_BAR   = 5 * MiB;
constexpr size_t WS_CNT   = 4 * MiB + 196608;
constexpr size_t WS_W     = 8 * MiB;
constexpr size_t W_IN0 = WS_W, W_GLU0 = W_IN0 + 4 * MiB, W_OUT0 = W_GLU0 + 2 * MiB;
constexpr size_t W_IN1 = W_OUT0 + 2 * MiB, W_OUT1 = W_IN1 + 5 * MiB;
constexpr size_t W_IN2 = W_OUT1 + 2 * MiB, W_GLU2 = W_IN2 + 4 * MiB, W_OUT2 = W_GLU2 + 2 * MiB;
constexpr size_t W_IN3 = W_OUT2 + 2 * MiB, W_OUT3 = W_IN3 + 5 * MiB;
constexpr size_t WS_BT1 = 40 * MiB;
constexpr size_t WS_BT3 = 72 * MiB;
constexpr size_t WS_XH  = 152 * MiB;
constexpr size_t WS_UH  = 280 * MiB;
constexpr size_t WS_GP  = 440 * MiB;
constexpr size_t WS_K   = WS_GP, WS_VT = WS_GP + 32 * MiB;
constexpr size_t WS_GATE = 504 * MiB;
constexpr size_t WS_ZG  = 632 * MiB;
constexpr size_t WS_OG  = 760 * MiB;
constexpr size_t WS_END = 888 * MiB;

#define XCD_BAR_WORDS 3456
struct Params { const float* in[36]; float* out; unsigned char* ws; };
extern __shared__ __attribute__((aligned(16))) unsigned char lds_raw[];
struct PV {
    __device__ __forceinline__ unsigned long long get(int i) const { const unsigned long long v = ((volatile LAS unsigned long long*)((LAS unsigned char*)lds_raw + 131072 + 16))[i]; const unsigned lo = __builtin_amdgcn_readfirstlane((unsigned)v), hi = __builtin_amdgcn_readfirstlane((unsigned)(v >> 32)); return ((unsigned long long)hi << 32) | lo; }
    __device__ __forceinline__ const float* in(int i) const { return (const float*)get(i); }
    __device__ __forceinline__ float* out() const { return (float*)get(36); }
    __device__ __forceinline__ unsigned char* ws() const { return (unsigned char*)get(37); }
};

constexpr int BM = 256, BK = 64, HALF = 128, HTB = HALF * BK * 2, STAGE_BYTES = 8 * HTB, NXCD = 8, WGM = 8;
__device__ __forceinline__ int lds_byte(int r, int c) { const int st = (r >> 4) * 2 + (c >> 5), rr = r & 15, cc = c & 31, ob = rr * 64 + cc * 2; return st * 1024 + (ob ^ (((ob >> 9) & 1) << 5)); }
__device__ __forceinline__ void stage_rc(int b, int& R, int& C) { const int st = b / 1024, sb = b % 1024, swz = sb ^ (((sb >> 9) & 1) << 5); R = (st >> 1) * 16 + swz / 64; C = (st & 1) * 32 + (swz % 64) / 2; }
__device__ __forceinline__ int perm32(int rho) { const int n = rho >> 4, i = rho & 15; return 8 * (i >> 2) + 4 * n + (i & 3); }

struct GUnit { const char* a; const char* b; int pm, pn, g, nt; };
struct AGeo { unsigned lda, slab; size_t kstep; };

struct PlainOrder {
    int nM, nN, nwg, G, c, nt; const char* A; const char* B; size_t ta, tb;
    __device__ __forceinline__ void init(int M, int N, int G_, int c_, const void* A_, size_t ta_, const void* B_, size_t tb_, int nt_ = 16) { nt = nt_; nM = M / BM; nN = N / BM; nwg = nM * nN; G = G_; c = c_; A = (const char*)A_; B = (const char*)B_; ta = ta_; tb = tb_; }
    __device__ __forceinline__ bool next(int i, GUnit& u) const {
        const long L = (long)i * G + c; if (L >= nwg) return false;
        int wgid = (int)L; { const int q = nwg / NXCD, r = nwg % NXCD, xcd = wgid % NXCD, off = wgid / NXCD; wgid = (xcd < r ? xcd * (q + 1) : r * (q + 1) + (xcd - r) * q) + off; }
        const int nig = WGM * nN, gid = wgid / nig, fm = gid * WGM, gsz = (nM - fm) < WGM ? (nM - fm) : WGM;
        u.pm = fm + ((wgid % nig) % gsz); u.pn = (wgid % nig) / gsz; u.g = 0; u.nt = nt;
        u.a = A + (size_t)u.pm * ta; u.b = B + (size_t)u.pn * tb; return true;
    }
};
struct GroupOrderS1 {
    int G, c; const char* A; const char* B; size_t gsa, gsb, ta;
    __device__ __forceinline__ bool next(int i, GUnit& u) const {
        const long L = (long)i * G + c; if (L >= 512) return false;
        int g, pm;
        if (G == 256) { const int xcd = c & 7, j = c >> 3; g = i * 32 + xcd * 4 + (j >> 3); pm = j & 7; }
        else { g = (int)(L >> 3); pm = (int)(L & 7); }
        u.g = g; u.pm = pm; u.pn = 0; u.nt = 8; u.a = A + (size_t)g * gsa + (size_t)pm * ta; u.b = B + (size_t)g * gsb; return true;
    }
};
struct GroupOrderS3 {
    int G, c; const char* A; const char* B; size_t gsa, gsb, ta, tb;
    __device__ __forceinline__ bool next(int i, GUnit& u) const {
        const long L = (long)i * G + c; if (L >= 1024) return false;
        int g, pm, pn;
        if (G == 256) { const int xcd = c & 7, j = c >> 3, rem = j & 15; g = i * 16 + xcd * 2 + (j >> 4); pm = rem >> 1; pn = (rem & 1) ^ (i & 1); }
        else { g = (int)(L >> 4); pm = (int)((L >> 1) & 7); pn = (int)(L & 1); }
        u.g = g; u.pm = pm; u.pn = pn; u.nt = pn ? 10 : 6; u.a = A + (size_t)g * gsa + (size_t)pm * ta; u.b = B + (size_t)g * gsb + (size_t)pn * tb; return true;
    }
};

template <class T, class = void> struct epi_half_n { static constexpr bool value = false; };
template <class T> struct epi_half_n<T, decltype((void)T::HALF_N)> { static constexpr bool value = T::HALF_N; };
template <class Epi, class Sched>
__device__ __forceinline__ void gemm_phase(LAS unsigned char* lds, const int wave_s, const AGeo ga, const unsigned ldb, const Sched& S, const Epi& E) {
    constexpr bool half_n = epi_half_n<Epi>::value;
    const int tid = get_tid(wave_s);
    const int wid = __builtin_amdgcn_readfirstlane(tid >> 6), lane = tid & 63, wr = wid >> 2, wc = wid & 3, fr = lane & 15, fq = lane >> 4;
    unsigned voffA[2], voffB[2];
#pragma unroll
    for (int i = 0; i < 2; ++i) { int R, C; stage_rc(tid * 16 + i * 8192, R, C); const int Rb = (R & ~31) + perm32(R & 31);
        voffA[i] = (unsigned)R * ga.lda + (unsigned)(C >> 4) * ga.slab + (unsigned)(C & 15) * 2u; voffB[i] = (unsigned)Rb * ldb + (unsigned)C * 2u; }
    const size_t kA = ga.kstep, kB = 128;
    const size_t hA = (size_t)HALF * ga.lda, hB = (size_t)HALF * ldb;
    const unsigned ldsw = (unsigned)wid * 1024u;
    const int aoff = lds_byte(wr * 64 + fr, fq * 8), boff = lds_byte(wc * 32 + fr, fq * 8);
#define PG8_SA(b, h) (((b) * 2 + (h)) * HTB)
#define PG8_SB(b, h) ((4 + (b) * 2 + (h)) * HTB)
#define PG8_STAGE(bufoff, gbase, voff) do { _Pragma("unroll") for (int _i = 0; _i < 2; ++_i) \
        __builtin_amdgcn_global_load_lds((const unsigned*)((const char*)(gbase) + (voff)[_i]), (LAS unsigned*)(lds + (bufoff) + ldsw + _i * 8192), 16, 0, 0); } while (0)
#define PG8_LDA(dst, b, h) do { _Pragma("unroll") for (int m = 0; m < 4; ++m) _Pragma("unroll") for (int k = 0; k < 2; ++k) dst[m][k] = *(const LAS h8*)(lds + PG8_SA(b, h) + aoff + m * 2048 + k * 1024); } while (0)
#define PG8_LDB(dst, b, h) do { _Pragma("unroll") for (int n = 0; n < 2; ++n) _Pragma("unroll") for (int k = 0; k < 2; ++k) dst[n][k] = *(const LAS h8*)(lds + PG8_SB(b, h) + boff + n * 2048 + k * 1024); } while (0)
#define PG8_MMA(ai, bj, At, Bt) do { __builtin_amdgcn_s_setprio(1); _Pragma("unroll") for (int m = 0; m < 4; ++m) _Pragma("unroll") for (int n = 0; n < 2; ++n) _Pragma("unroll") for (int k = 0; k < 2; ++k) \
        acc[ai][bj][m][n] = __builtin_amdgcn_mfma_f32_16x16x32_f16(Bt[n][k], At[m][k], acc[ai][bj][m][n], 0, 0, 0); __builtin_amdgcn_s_setprio(0); } while (0)
#define PG8_WAIT_V(n) asm volatile("s_waitcnt vmcnt(" #n ")" ::: "memory")
#define PG8_WAIT_L(n) asm volatile("s_waitcnt lgkmcnt(" #n ")" ::: "memory")
#define PG8_BAR __builtin_amdgcn_s_barrier()
#define PG8_SCHED __builtin_amdgcn_sched_barrier(0)
    GUnit cur, nxt; int ui = 0;
    if (!S.next(0, cur)) return;
    f32x4 acc[2][2][4][2];
#pragma unroll
    for (int a = 0; a < 2; ++a)
#pragma unroll
        for (int b = 0; b < 2; ++b)
#pragma unroll
            for (int m = 0; m < 4; ++m)
#pragma unroll
                for (int n = 0; n < 2; ++n) acc[a][b][m][n] = (f32x4){0.f, 0.f, 0.f, 0.f};
    h8 At[4][2], B0[2][2], B1[2][2];
    const char* cA = cur.a; const char* cB = cur.b;
    PG8_STAGE(PG8_SB(0, 0), cB, voffB); PG8_STAGE(PG8_SB(0, 1), cB + hB, voffB); PG8_STAGE(PG8_SA(0, 0), cA, voffA); PG8_STAGE(PG8_SA(0, 1), cA + hA, voffA);
    if (wr == 1) PG8_BAR;
    PG8_WAIT_V(2); PG8_BAR;
    PG8_STAGE(PG8_SB(1, 0), cB + kB, voffB); PG8_STAGE(PG8_SA(1, 0), cA + kA, voffA); PG8_STAGE(PG8_SB(1, 1), cB + hB + kB, voffB);
    PG8_WAIT_V(6); PG8_BAR;
    for (;;) {
        const bool has_next = S.next(ui + 1, nxt);
        const char* nA = has_next ? nxt.a : cA; const char* nB = has_next ? nxt.b : cB;
        const int nt = cur.nt;
#pragma unroll 1
        for (int t = 0; t < nt; t += 2) {
            const bool last = (t == nt - 2);
            const char* a1 = cA + (size_t)(t + 1) * kA;
            const char* a2 = last ? nA : cA + (size_t)(t + 2) * kA; const char* b2 = last ? nB : cB + (size_t)(t + 2) * kB;
            const char* a3 = a2 + kA; const char* b3 = b2 + kB;
            PG8_LDB(B0, 0, 0); PG8_LDB(B1, 0, 1); PG8_SCHED; PG8_LDA(At, 0, 0); PG8_STAGE(PG8_SA(1, 1), a1 + hA, voffA);
            PG8_WAIT_V(8); PG8_WAIT_L(0); PG8_BAR; PG8_MMA(0, 0, At, B0); if constexpr (!half_n) PG8_MMA(0, 1, At, B1); PG8_BAR; PG8_SCHED;
            PG8_LDA(At, 0, 1); PG8_STAGE(PG8_SB(0, 0), b2, voffB); PG8_STAGE(PG8_SB(0, 1), b2 + hB, voffB); PG8_STAGE(PG8_SA(0, 0), a2, voffA);
            PG8_WAIT_V(8); PG8_WAIT_L(0); PG8_BAR; PG8_MMA(1, 0, At, B0); if constexpr (!half_n) PG8_MMA(1, 1, At, B1); PG8_BAR; PG8_SCHED;
            PG8_LDB(B0, 1, 0); PG8_LDB(B1, 1, 1); PG8_SCHED; PG8_LDA(At, 1, 0); PG8_STAGE(PG8_SA(0, 1), a2 + hA, voffA);
            PG8_WAIT_V(8); PG8_WAIT_L(0); PG8_BAR; PG8_MMA(0, 0, At, B0); if constexpr (!half_n) PG8_MMA(0, 1, At, B1); PG8_BAR; PG8_SCHED;
            PG8_LDA(At, 1, 1); PG8_STAGE(PG8_SB(1, 0), b3, voffB); PG8_STAGE(PG8_SB(1, 1), b3 + hB, voffB); PG8_STAGE(PG8_SA(1, 0), a3, voffA);
            PG8_WAIT_V(8); PG8_WAIT_L(0); PG8_BAR; PG8_MMA(1, 0, At, B0); if constexpr (!half_n) PG8_MMA(1, 1, At, B1); PG8_BAR; PG8_SCHED;
        }
        if (wr == 0) PG8_BAR;
        E(acc, cur, wr, wc, fr, fq);
        if (!has_next) break;
#pragma unroll
        for (int a = 0; a < 2; ++a)
#pragma unroll
            for (int b = 0; b < 2; ++b)
#pragma unroll
                for (int m = 0; m < 4; ++m)
#pragma unroll
                    for (int n = 0; n < 2; ++n) acc[a][b][m][n] = (f32x4){0.f, 0.f, 0.f, 0.f};
        cur = nxt; cA = nA; cB = nB; ++ui;
        if (wr == 1) PG8_BAR;
    }
    PG8_WAIT_V(0);
    PG8_BAR;
#undef PG8_SA
#undef PG8_SB
#undef PG8_STAGE
#undef PG8_LDA
#undef PG8_LDB
#undef PG8_MMA
#undef PG8_WAIT_V
#undef PG8_WAIT_L
#undef PG8_BAR
#undef PG8_SCHED
}

__device__ __forceinline__ h8 pack8(f32x4 a, f32x4 b) { h8 r; r[0] = (h16)a[0]; r[1] = (h16)a[1]; r[2] = (h16)a[2]; r[3] = (h16)a[3]; r[4] = (h16)b[0]; r[5] = (h16)b[1]; r[6] = (h16)b[2]; r[7] = (h16)b[3]; return r; }
__device__ __forceinline__ float sigmoidf_(float x) { return __builtin_amdgcn_rcpf(1.0f + __expf(-x)); }

struct EpiG1Ssm {
    const float* sumsq; h16* UH; h16* gate;
    __device__ __forceinline__ void operator()(const f32x4 (&acc)[2][2][4][2], const GUnit& u, int wr, int wc, int fr, int fq) const {
#pragma unroll
        for (int ai = 0; ai < 2; ++ai)
#pragma unroll
            for (int m = 0; m < 4; ++m) {
                const int row = u.pm * BM + ai * HALF + wr * 64 + m * 16 + fr;
                const float rs = rsqrtf(sumsq[row] * (1.0f / DM) + NORM_EPS);
#pragma unroll
                for (int bj = 0; bj < 2; ++bj) {
                    const int ch0 = u.pn * BM + bj * HALF + wc * 32 + 8 * fq;
                    const h8 v = pack8(acc[ai][bj][m][0] * rs, acc[ai][bj][m][1] * rs);
                    if (ch0 < 1024) { const int g = ch0 >> 4, c0 = ch0 & 15;
                        *(h8*)(UH + ((size_t)g * ROWS_G + (row >> 5)) * UHK + 128 + (row & 31) * 16 + c0) = v; }
                    else *(h8*)(gate + (size_t)row * DM + (ch0 - 1024)) = v;
                }
            }
    }
};
struct EpiS1 {
    static constexpr bool HALF_N = true;
    float* Gp;
    __device__ __forceinline__ void operator()(const f32x4 (&acc)[2][2][4][2], const GUnit& u, int wr, int wc, int fr, int fq) const {
#pragma unroll
        for (int ai = 0; ai < 2; ++ai)
#pragma unroll
            for (int m = 0; m < 4; ++m) {
                const int row = u.pm * BM + ai * HALF + wr * 64 + m * 16 + fr;
                float* p = Gp + ((size_t)u.g * ROWS_G + row) * 128 + wc * 32 + 8 * fq;
                *(f32x4*)p = acc[ai][0][m][0]; *(f32x4*)(p + 4) = acc[ai][0][m][1];
            }
    }
};
struct EpiS3 {
    const float* stepv; h16* Zg;
    static __device__ __forceinline__ float gelu1(float a) { return a * __builtin_amdgcn_rcpf(1.0f + __expf(-1.5957691216f * (a + 0.044715f * a * a * a))); }
    __device__ __forceinline__ void operator()(const f32x4 (&acc)[2][2][4][2], const GUnit& u, int wr, int wc, int fr, int fq) const {
        const float st = stepv[u.g];
        h16* base = Zg + (size_t)u.g * M_TOK * 16 + (size_t)(u.pm * BM + wr * 64 + fr) * 512 + u.pn * 256 + wc * 32 + 8 * fq;
#pragma unroll
        for (int ai = 0; ai < 2; ++ai)
#pragma unroll
            for (int m = 0; m < 4; ++m) {
#pragma unroll
                for (int bj = 0; bj < 2; ++bj) {
                    const f32x4 y0 = acc[ai][bj][m][0] * st, y1 = acc[ai][bj][m][1] * st;
                    h8 o;
#pragma unroll
                    for (int j = 0; j < 4; ++j) { o[j] = (h16)gelu1(y0[j]); o[4 + j] = (h16)gelu1(y1[j]); }
                    *(h8*)(base + (size_t)(ai * HALF + m * 16) * 512 + bj * HALF) = o;
                    __builtin_amdgcn_sched_barrier(0);
                }
            }
    }
};
struct EpiGlu {
    const h16* Zg; const h16* gate; const float* bias; h16* og;
    __device__ __forceinline__ void operator()(const f32x4 (&acc)[2][2][4][2], const GUnit& u, int wr, int wc, int fr, int fq) const {
        const int rowb = u.pm * BM + wr * 64 + fr, nb = u.pn * BM + wc * 32 + 8 * fq;
        h8 zb[3], gb[3];
#define GLU_ISSUE(gi) do { const int bj_ = (gi) >> 3, ai_ = ((gi) >> 2) & 1, m_ = (gi) & 3, n0_ = nb + bj_ * HALF, row_ = rowb + ai_ * HALF + m_ * 16; \
            zb[(gi) % 3] = *(const h8*)(Zg + ((size_t)(n0_ >> 4) * M_TOK + row_) * 16 + (n0_ & 15)); gb[(gi) % 3] = *(const h8*)(gate + (size_t)row_ * DM + n0_); } while (0)
        GLU_ISSUE(0); GLU_ISSUE(1);
        f32x4 b0, b1;
#pragma unroll
        for (int gi = 0; gi < 16; ++gi) {
            if (gi + 2 < 16) GLU_ISSUE(gi + 2);
            const int bj = gi >> 3, ai = (gi >> 2) & 1, m = gi & 3, n0 = nb + bj * HALF, row = rowb + ai * HALF + m * 16;
            if ((gi & 7) == 0) { b0 = *(const f32x4*)(bias + n0); b1 = *(const f32x4*)(bias + n0 + 4); }
            const h8 z = zb[gi % 3], gt = gb[gi % 3];
            const f32x4 a0 = acc[ai][bj][m][0] + b0, a1 = acc[ai][bj][m][1] + b1;
            h8 o;
#pragma unroll
            for (int j = 0; j < 4; ++j) {
                const float g0 = (float)gt[j], g1 = (float)gt[4 + j];
                o[j] = (h16)((float)z[j] * g0 * __builtin_amdgcn_rcpf((1.0f + __expf(-a0[j])) * (1.0f + __expf(-g0))));
                o[4 + j] = (h16)((float)z[4 + j] * g1 * __builtin_amdgcn_rcpf((1.0f + __expf(-a1[j])) * (1.0f + __expf(-g1))));
            }
            *(h8*)(og + (size_t)row * DM + n0) = o;
            __builtin_amdgcn_sched_barrier(0);
        }
#undef GLU_ISSUE
    }
};
struct EpiOut {
    h16* xh; float* sumsq;
    __device__ __forceinline__ void operator()(const f32x4 (&acc)[2][2][4][2], const GUnit& u, int wr, int wc, int fr, int fq) const {
        const int rowb = u.pm * BM + wr * 64 + fr, nb = u.pn * BM + wc * 32 + 8 * fq;
        h8 xb[8][2];
#define OUT_ISSUE(gi) do { _Pragma("unroll") for (int bj = 0; bj < 2; ++bj) xb[gi][bj] = *(const h8*)(xh + (size_t)(rowb + ((gi) >> 2) * HALF + ((gi) & 3) * 16) * DM + nb + bj * HALF); } while (0)
#pragma unroll
        for (int gi = 0; gi < 5; ++gi) OUT_ISSUE(gi);
#pragma unroll
        for (int gi = 0; gi < 8; ++gi) {
            if (gi + 5 < 8) OUT_ISSUE(gi + 5);
            const int ai = gi >> 2, m = gi & 3, row = rowb + ai * HALF + m * 16;
            float ss = 0.f;
#pragma unroll
            for (int bj = 0; bj < 2; ++bj) {
                const h8 xo = xb[gi][bj];
                f32x4 v0, v1;
#pragma unroll
                for (int j = 0; j < 4; ++j) { v0[j] = (float)xo[j] + acc[ai][bj][m][0][j]; v1[j] = (float)xo[4 + j] + acc[ai][bj][m][1][j]; }
                const h8 xn = pack8(v0, v1); *(h8*)(xh + (size_t)row * DM + nb + bj * HALF) = xn;
#pragma unroll
                for (int j = 0; j < 4; ++j) { const float a = (float)xn[j], b = (float)xn[4 + j]; ss += a * a + b * b; }
            }
            ss += __shfl_xor(ss, 16); ss += __shfl_xor(ss, 32);
            if (fq == 0) atomicAdd(sumsq + row, ss);
            __builtin_amdgcn_sched_barrier(0);
        }
#undef OUT_ISSUE
    }
};
struct EpiOutFinal {
    const h16* xh; float* out; float* sumsq; unsigned* cnt; const float* gfin;
    __device__ __forceinline__ void operator()(f32x4 (&acc)[2][2][4][2], const GUnit& u, int wr, int wc, int fr, int fq) const {
        const int rowb = u.pm * BM + wr * 64 + fr, nb = u.pn * BM + wc * 32 + 8 * fq;
        float dummy = 0.f;
#pragma unroll
        for (int ai = 0; ai < 2; ++ai)
#pragma unroll
            for (int m = 0; m < 4; ++m) {
                const int row = rowb + ai * HALF + m * 16;
                float ss = 0.f;
#pragma unroll
                for (int bj = 0; bj < 2; ++bj) {
                    const h8 xo = *(const h8*)(xh + (size_t)row * DM + nb + bj * HALF);
#pragma unroll
                    for (int j = 0; j < 4; ++j) { const float a = (float)xo[j] + acc[ai][bj][m][0][j], b = (float)xo[4 + j] + acc[ai][bj][m][1][j]; acc[ai][bj][m][0][j] = a; acc[ai][bj][m][1][j] = b; ss += a * a + b * b; }
                }
                ss += __shfl_xor(ss, 16); ss += __shfl_xor(ss, 32);
                if (fq == 0) dummy += atomicAdd(sumsq + row, ss);
            }
        asm volatile("s_waitcnt vmcnt(0)" :: "v"(dummy) : "memory");
        if (fr == 0 && fq == 0) __hip_atomic_fetch_add(cnt + u.pm, 1u, __ATOMIC_RELAXED, __HIP_MEMORY_SCOPE_AGENT);
        if (wr == 0 && wc == 0 && fr == 0 && fq == 0) { while (__hip_atomic_load(cnt + u.pm, __ATOMIC_RELAXED, __HIP_MEMORY_SCOPE_AGENT) < 32u) __builtin_amdgcn_s_sleep(2); }
        __builtin_amdgcn_s_barrier();
        f32x4 g[2][2];
#pragma unroll
        for (int bj = 0; bj < 2; ++bj) { g[bj][0] = *(const f32x4*)(gfin + nb + bj * HALF); g[bj][1] = *(const f32x4*)(gfin + nb + bj * HALF + 4); }
#pragma unroll
        for (int ai = 0; ai < 2; ++ai)
#pragma unroll
            for (int m = 0; m < 4; ++m) {
                const int row = rowb + ai * HALF + m * 16;
                const float rs = rsqrtf(__hip_atomic_load(sumsq + row, __ATOMIC_RELAXED, __HIP_MEMORY_SCOPE_AGENT) * (1.0f / DM) + NORM_EPS);
#pragma unroll
                for (int bj = 0; bj < 2; ++bj) { float* o = out + (size_t)row * DM + nb + bj * HALF;
                    *(f32x4*)o = acc[ai][bj][m][0] * rs * g[bj][0]; *(f32x4*)(o + 4) = acc[ai][bj][m][1] * rs * g[bj][1]; }
            }
    }
};
struct EpiOutLast {
    const h16* xh; float* out; float* sumsq;
    __device__ __forceinline__ void operator()(const f32x4 (&acc)[2][2][4][2], const GUnit& u, int wr, int wc, int fr, int fq) const {
        const int rowb = u.pm * BM + wr * 64 + fr, nb = u.pn * BM + wc * 32 + 8 * fq;
#pragma unroll
        for (int ai = 0; ai < 2; ++ai)
#pragma unroll
            for (int m = 0; m < 4; ++m) {
                const int row = rowb + ai * HALF + m * 16;
                float ss = 0.f;
#pragma unroll
                for (int bj = 0; bj < 2; ++bj) {
                    const size_t off = (size_t)row * DM + nb + bj * HALF;
                    const h8 xo = *(const h8*)(xh + off); f32x4 v0, v1;
#pragma unroll
                    for (int j = 0; j < 4; ++j) { v0[j] = (float)xo[j] + acc[ai][bj][m][0][j]; v1[j] = (float)xo[4 + j] + acc[ai][bj][m][1][j]; ss += v0[j] * v0[j] + v1[j] * v1[j]; }
                    *(f32x4*)(out + off) = v0; *(f32x4*)(out + off + 4) = v1;
                }
                ss += __shfl_xor(ss, 16); ss += __shfl_xor(ss, 32);
                if (fq == 0) atomicAdd(sumsq + row, ss);
            }
    }
};
struct EpiG1Att {
    const float* sumsq; const f32x2* rope; h16* q; h16* k; h16* vt; h16* gate;
    __device__ __forceinline__ void operator()(const f32x4 (&acc)[2][2][4][2], const GUnit& u, int wr, int wc, int fr, int fq) const {
#pragma unroll
        for (int ai = 0; ai < 2; ++ai)
#pragma unroll
            for (int m = 0; m < 4; ++m) {
                const int row = u.pm * BM + ai * HALF + wr * 64 + m * 16 + fr;
                const int l = row & (SEQ - 1);
                const float rs = rsqrtf(sumsq[row] * (1.0f / DM) + NORM_EPS);
#pragma unroll
                for (int bj = 0; bj < 2; ++bj) {
                    const int ct = bj * HALF + wc * 32 + 8 * fq;
                    f32x4 v0 = acc[ai][bj][m][0] * rs, v1 = acc[ai][bj][m][1] * rs;
                    if (u.pn < 4 || (u.pn == 4 && bj == 0)) {
                        const int i0 = (ct & 63) >> 1;
                        const f32x2 cs0 = rope[l * 32 + i0], cs1 = rope[l * 32 + i0 + 1], cs2 = rope[l * 32 + i0 + 2], cs3 = rope[l * 32 + i0 + 3];
                        const float sc = (u.pn < 4) ? 0.125f * LOG2E : 1.0f;
                        f32x4 r0, r1;
                        r0[0] = (v0[0] * cs0.x - v0[1] * cs0.y) * sc; r0[1] = (v0[1] * cs0.x + v0[0] * cs0.y) * sc;
                        r0[2] = (v0[2] * cs1.x - v0[3] * cs1.y) * sc; r0[3] = (v0[3] * cs1.x + v0[2] * cs1.y) * sc;
                        r1[0] = (v1[0] * cs2.x - v1[1] * cs2.y) * sc; r1[1] = (v1[1] * cs2.x + v1[0] * cs2.y) * sc;
                        r1[2] = (v1[2] * cs3.x - v1[3] * cs3.y) * sc; r1[3] = (v1[3] * cs3.x + v1[2] * cs3.y) * sc;
                        const h8 o = pack8(r0, r1);
                        if (u.pn < 4) *(h8*)(q + (size_t)row * DM + u.pn * BM + ct) = o;
                        else *(h8*)(k + (size_t)row * 128 + ct) = o;
                    } else if (u.pn == 4) {
                        *(h8*)(vt + (size_t)row * 128 + (ct - 128)) = pack8(v0, v1);
                    } else {
                        f32x4 s0, s1;
#pragma unroll
                        for (int j = 0; j < 4; ++j) { s0[j] = v0[j] * sigmoidf_(v0[j]); s1[j] = v1[j] * sigmoidf_(v1[j]); }
                        *(h8*)(gate + (size_t)row * DM + (u.pn - 5) * BM + ct) = pack8(s0, s1);
                    }
                }
            }
    }
};

__device__ __forceinline__ float wave_sum(float v) {
#pragma unroll
    for (int o = 1; o < 64; o <<= 1) v += __shfl_xor(v, o);
    return v;
}
template <int MODE>
__device__ __forceinline__ void transpose_item(const float* W, int K, int N, h16* WT, const float* gsc, LAS float* scr, int item, int lane) {
    const int nblk = N / 32, kb = item / nblk, nb = item % nblk, k0 = 64 * kb, n0 = 32 * nb;
    const int nd = n0 + (lane & 31); int src = nd;
    if (MODE == 1 && nd < 1152) { const int j = nd & 63; src = (nd & ~63) + (j >> 1) + 32 * (j & 1); }
    float wv[32];
#pragma unroll
    for (int i = 0; i < 32; ++i) wv[i] = W[(size_t)(k0 + 2 * i + (lane >> 5)) * N + src];
#pragma unroll
    for (int i = 0; i < 32; ++i) { const int kk = 2 * i + (lane >> 5); float v = wv[i]; if (gsc) v *= gsc[k0 + kk]; scr[kk * 33 + (lane & 31)] = v; }
    asm volatile("s_waitcnt lgkmcnt(0)" ::: "memory");
    const int c = lane & 7;
#pragma unroll
    for (int j = 0; j < 4; ++j) { const int n = (lane >> 3) + 8 * j; const LAS float* s = scr + (8 * c) * 33 + n;
        h8 o; o[0] = (h16)s[0 * 33]; o[1] = (h16)s[1 * 33]; o[2] = (h16)s[2 * 33]; o[3] = (h16)s[3 * 33]; o[4] = (h16)s[4 * 33]; o[5] = (h16)s[5 * 33]; o[6] = (h16)s[6 * 33]; o[7] = (h16)s[7 * 33];
        *(h8*)(WT + (size_t)(n0 + n) * K + k0 + 8 * c) = o; }
    asm volatile("s_waitcnt lgkmcnt(0)" ::: "memory");
}

__device__ __forceinline__ void ssm_prep_item(const PV& P, int L, int g, LAS unsigned char* lds, const int tid) {
    const int base = (L == 0) ? 1 : 18;
    const float* a_re = P.in(base + 2) + g * 64; const float* a_im = P.in(base + 3) + g * 64; const float* log_step = P.in(base + 4);
    const float* b_re = P.in(base + 5) + g * 1024; const float* b_im = P.in(base + 6) + g * 1024;
    const float* c_re = P.in(base + 7) + g * 1024; const float* c_im = P.in(base + 8) + g * 1024;
    const float* dsk = P.in(base + 9) + g * 16;
    LAS float* apr = (LAS float*)lds;
    LAS float* api = apr + 64 * 33;
    LAS float* bbr = api + 64 * 33;
    LAS float* bbi = bbr + 1024;
    LAS float* km = bbi + 1024;
    LAS float* crs = km + 8192;
    LAS float* cis = crs + 1024;
    LAS float* cof = cis + 1024;
    const double step = exp((double)log_step[g]);
    for (int e = tid; e < 1024; e += 512) { crs[e] = c_re[e]; cis[e] = c_im[e]; }
    for (int e = tid; e < 64 * 33; e += 512) { const int p = e / 33, k = e % 33; const double mag = exp((double)k * step * (double)a_re[p]), ang = (double)k * step * (double)a_im[p];
        apr[e] = (float)(mag * cos(ang)); api[e] = (float)(mag * sin(ang)); }
    if (tid < 64) { const int p = tid; const double lr = a_re[p], li = a_im[p]; const double mag = exp(step * lr), ang = step * li;
        const double er = mag * cos(ang) - 1.0, ei = mag * sin(ang); const double den = (lr * lr + li * li) * step;
        cof[2 * p] = (float)((er * lr + ei * li) / den); cof[2 * p + 1] = (float)((ei * lr - er * li) / den); }
    __syncthreads();
    for (int e = tid; e < 1024; e += 512) { const int p = e >> 4; const float cr = cof[2 * p], ci = cof[2 * p + 1]; const float br = b_re[e], bi = b_im[e];
        bbr[e] = cr * br - ci * bi; bbi[e] = cr * bi + ci * br; }
    __syncthreads();
    { const int lag = tid >> 4, c = tid & 15;
      float acc[16];
#pragma unroll
      for (int j = 0; j < 16; ++j) acc[j] = 0.f;
      for (int p = 0; p < 64; ++p) { const float ar = apr[p * 33 + lag], ai = api[p * 33 + lag], cr = crs[c * 64 + p], ci = cis[c * 64 + p];
          const float wr_ = cr * ar - ci * ai, wi_ = cr * ai + ci * ar;
#pragma unroll
          for (int j = 0; j < 16; ++j) acc[j] += wr_ * bbr[p * 16 + j] - wi_ * bbi[p * 16 + j]; }
#pragma unroll
      for (int j = 0; j < 16; ++j) km[(lag << 8) + (c << 4) + j] = acc[j]; }
    __syncthreads();
    const float inv_step = (float)(1.0 / step);
    h16* bt3 = (h16*)(P.ws() + WS_BT3) + (size_t)(L * 64 + g) * 512 * 640;
    for (int ch = tid; ch < 512 * 80; ch += 512) { const int n = ch / 80, k0 = (ch % 80) * 8, t = n >> 4, c = n & 15;
        if (n < 256 && k0 >= 384) continue;
        h8 o;
        if (k0 < 128) {
#pragma unroll
            for (int j = 0; j < 8; ++j) { const int kk = k0 + j, p = kk & 63; const float ar = apr[p * 33 + t + 1], ai = api[p * 33 + t + 1], cr = crs[c * 64 + p], ci = cis[c * 64 + p];
                o[j] = (h16)((kk < 64) ? (cr * ar - ci * ai) : -(cr * ai + ci * ar)); }
        } else { const int s_ = (k0 - 128) >> 4, cp0 = (k0 - 128) & 15;
#pragma unroll
            for (int j = 0; j < 8; ++j) { const int cp = cp0 + j; float v = (s_ <= t) ? km[((t - s_) << 8) + (c << 4) + cp] : 0.f; if (s_ == t && c == cp) v += dsk[c] * inv_step; o[j] = (h16)v; }
        }
        *(h8*)(bt3 + (size_t)n * 640 + k0) = o; }
    h16* bt1 = (h16*)(P.ws() + WS_BT1) + (size_t)(L * 64 + g) * 256 * 512;
    for (int ch = tid; ch < 256 * 64; ch += 512) { const int n = ch >> 6, k0 = (ch & 63) * 8, s_ = k0 >> 4, c0 = k0 & 15;
        h8 o;
        if (n < 128) { const int p = n & 63; const float ar = apr[p * 33 + 31 - s_], ai = api[p * 33 + 31 - s_];
#pragma unroll
            for (int j = 0; j < 8; ++j) { const float br = bbr[p * 16 + c0 + j], bi = bbi[p * 16 + c0 + j]; o[j] = (h16)((n < 64) ? (ar * br - ai * bi) : (ar * bi + ai * br)); }
        } else {
#pragma unroll
            for (int j = 0; j < 8; ++j) o[j] = (h16)0.f; }
        *(h8*)(bt1 + (size_t)n * 512 + k0) = o; }
    if (tid < 64) { const int p = tid; f32x2* a16 = (f32x2*)(P.ws() + WS_A16) + (L * 64 + g) * 64; f32x2* asg = (f32x2*)(P.ws() + WS_ASEG) + (L * 64 + g) * 64;
        a16[p] = (f32x2){apr[p * 33 + 32], api[p * 33 + 32]};
        const double mag = exp(2048.0 * step * (double)a_re[p]), ang = 2048.0 * step * (double)a_im[p]; asg[p] = (f32x2){(float)(mag * cos(ang)), (float)(mag * sin(ang))}; }
    if (tid == 0) ((float*)(P.ws() + WS_STEP))[L * 64 + g] = (float)step;
    __syncthreads();
}

__device__ __forceinline__ void prep_phase(const PV& P, LAS unsigned char* lds, const int wave_s) {
    const int tid = get_tid(wave_s);
    const int lane = tid & 63, wave = tid >> 6, G = gridDim.x;
    const bool split = (G == 256);
    const bool builder = true;
    const int GB = G;
    const int gw = blockIdx.x * 8 + wave, NGW = GB * 8;
    unsigned char* ws = P.ws();
    if (builder) {
    for (int it = blockIdx.x; it < 128; it += GB) ssm_prep_item(P, it >> 6, it & 63, lds, tid);
    __syncthreads();
    { float* ss = (float*)(P.ws() + WS_SUMSQ) + M_TOK; for (size_t i = (size_t)blockIdx.x * 512 + tid; i < (size_t)4 * M_TOK; i += (size_t)GB * 512) ss[i] = 0.f; }
    if (blockIdx.x == 0) { if (tid < 256) ((unsigned*)(P.ws() + WS_CNT))[tid] = 0u; for (int i = tid; i < XCD_BAR_WORDS; i += 512) ((unsigned*)(P.ws() + WS_BAR))[i] = 0u; }
    { f32x2* rope = (f32x2*)(P.ws() + WS_ROPE);
      const float inv = (float)exp2(-(double)(2 * (tid & 31)) / 64.0 * 13.287712379549449);
      for (int e = blockIdx.x * 512 + tid; e < SEQ * 32; e += GB * 512) { const int l = e >> 5; const float ang = (float)l * inv;
          rope[e] = (f32x2){(float)cos((double)ang), (float)sin((double)ang)}; } }
    LAS float* scr = (LAS float*)(lds + wave * 8704);
    constexpr int I_IN_S = 16 * 64, I_SQ = 16 * 32, I_IN_A = 16 * 72;
    constexpr int NITEMS = 2 * (I_IN_S + 2 * I_SQ) + 2 * (I_IN_A + I_SQ);
    for (int it = gw; it < NITEMS; it += NGW) {
        int r = it;
        if (r < I_IN_S) { transpose_item<0>(P.in(2), 1024, 2048, (h16*)(ws + W_IN0), P.in(1), scr, r, lane); continue; } r -= I_IN_S;
        if (r < I_SQ) { transpose_item<0>(P.in(11), 1024, 1024, (h16*)(ws + W_GLU0), nullptr, scr, r, lane); continue; } r -= I_SQ;
        if (r < I_SQ) { transpose_item<0>(P.in(13), 1024, 1024, (h16*)(ws + W_OUT0), nullptr, scr, r, lane); continue; } r -= I_SQ;
        if (r < I_IN_A) { transpose_item<1>(P.in(15), 1024, 2304, (h16*)(ws + W_IN1), P.in(14), scr, r, lane); continue; } r -= I_IN_A;
        if (r < I_SQ) { transpose_item<0>(P.in(17), 1024, 1024, (h16*)(ws + W_OUT1), nullptr, scr, r, lane); continue; } r -= I_SQ;
        if (r < I_IN_S) { transpose_item<0>(P.in(19), 1024, 2048, (h16*)(ws + W_IN2), P.in(18), scr, r, lane); continue; } r -= I_IN_S;
        if (r < I_SQ) { transpose_item<0>(P.in(28), 1024, 1024, (h16*)(ws + W_GLU2), nullptr, scr, r, lane); continue; } r -= I_SQ;
        if (r < I_SQ) { transpose_item<0>(P.in(30), 1024, 1024, (h16*)(ws + W_OUT2), nullptr, scr, r, lane); continue; } r -= I_SQ;
        if (r < I_IN_A) { transpose_item<1>(P.in(32), 1024, 2304, (h16*)(ws + W_IN3), P.in(31), scr, r, lane); continue; } r -= I_IN_A;
        transpose_item<0>(P.in(34), 1024, 1024, (h16*)(ws + W_OUT3), nullptr, scr, r, lane);
    }
    }
    { const float* x = P.in(0); h16* xh = (h16*)(ws + WS_XH); float* ss0 = (float*)(ws + WS_SUMSQ);
      int row0, nrows, stride;
      if (split) { if (blockIdx.x < 128) { row0 = gw * 16; nrows = 16; } else { row0 = 16384 + (gw - 1024) * 48; nrows = 48; } stride = 0; }
      else { row0 = gw * 4; nrows = M_TOK; stride = NGW * 4; }
      for (int r = 0; ; r += 4) {
          int row;
          if (stride == 0) { if (r >= nrows) break; row = row0 + r; } else { row = row0 + (r >> 2) * stride; if (row >= M_TOK) break; }
          f32x4 v[4][4];
#pragma unroll
          for (int q = 0; q < 4; ++q)
#pragma unroll
              for (int j = 0; j < 4; ++j) v[q][j] = ((const f32x4*)(x + (size_t)(row + q) * DM) + lane)[64 * j];
#pragma unroll
          for (int q = 0; q < 4; ++q) { h4* o = (h4*)(xh + (size_t)(row + q) * DM) + lane; float sq = 0.f;
#pragma unroll
              for (int j = 0; j < 4; ++j) { const f32x4 t = v[q][j]; sq += (t[0] * t[0] + t[1] * t[1]) + (t[2] * t[2] + t[3] * t[3]); h4 hv; hv[0] = (h16)t[0]; hv[1] = (h16)t[1]; hv[2] = (h16)t[2]; hv[3] = (h16)t[3]; o[64 * j] = hv; }
              sq = wave_sum(sq); if (lane == 0) ss0[row + q] = sq; }
      } }
}

__device__ __forceinline__ void s2_phase(const PV& P, int L, LAS unsigned char* lds, const int wave_s) {
    const int tid = get_tid(wave_s);
    const int lane = tid & 63, wave = tid >> 6, seg = wave & 3;
    LAS f32x2* E = (LAS f32x2*)lds;
    for (int gb0 = blockIdx.x * 2; gb0 < 512; gb0 += gridDim.x * 2) {
        const int gb = gb0 + (wave >> 2), g = gb >> 3, b = gb & 7;
        const f32x2 a = ((const f32x2*)(P.ws() + WS_A16))[(L * 64 + g) * 64 + lane];
        const f32x2 as = ((const f32x2*)(P.ws() + WS_ASEG))[(L * 64 + g) * 64 + lane];
        const float* Gp = (const float*)(P.ws() + WS_GP) + ((size_t)g * ROWS_G + b * 256 + seg * 64) * 128 + lane;
        float hr = 0.f, hi = 0.f;
        for (int n = 0; n < 64; n += 16) {
            float gr[16], gi[16];
#pragma unroll
            for (int j = 0; j < 16; ++j) { gr[j] = Gp[(size_t)(n + j) * 128]; gi[j] = Gp[(size_t)(n + j) * 128 + 64]; }
#pragma unroll
            for (int j = 0; j < 16; ++j) { const float t = a.x * hr - a.y * hi + gr[j]; hi = a.x * hi + a.y * hr + gi[j]; hr = t; }
        }
        E[wave * 64 + lane] = (f32x2){hr, hi};
        __syncthreads();
        float sr = 0.f, si = 0.f;
        for (int i = 0; i < seg; ++i) { const f32x2 e = E[((wave & ~3) + i) * 64 + lane]; const float t = as.x * sr - as.y * si + e.x; si = as.x * si + as.y * sr + e.y; sr = t; }
        h16* H = (h16*)(P.ws() + WS_UH) + ((size_t)g * ROWS_G + b * 256 + seg * 64) * UHK + lane;
        hr = sr; hi = si;
        for (int n = 0; n < 64; n += 16) {
            float gr[16], gi[16];
#pragma unroll
            for (int j = 0; j < 16; ++j) { gr[j] = Gp[(size_t)(n + j) * 128]; gi[j] = Gp[(size_t)(n + j) * 128 + 64]; }
#pragma unroll
            for (int j = 0; j < 16; ++j) { H[(size_t)(n + j) * UHK] = (h16)hr; H[(size_t)(n + j) * UHK + 64] = (h16)hi;
                const float t = a.x * hr - a.y * hi + gr[j]; hi = a.x * hi + a.y * hr + gi[j]; hr = t; }
        }
        __syncthreads();
    }
}

__device__ __forceinline__ int crow(int r, int hi) { return (r & 3) + 8 * (r >> 2) + 4 * hi; }
__device__ __forceinline__ void attn_phase(const PV& P, int layer, LAS unsigned char* lds, const int wave_s) {
    const h16* q = (const h16*)(P.ws() + WS_UH); const h16* k = (const h16*)(P.ws() + WS_K); const h16* vt = (const h16*)(P.ws() + WS_VT);
    const h16* gate = (const h16*)(P.ws() + WS_GATE); h16* og = (h16*)(P.ws() + WS_OG);
    const float* sinks = P.in(layer == 1 ? 16 : 33);
    const int tid = get_tid(wave_s);
    const int lane = tid & 63, wave = __builtin_amdgcn_readfirstlane(tid >> 6), l31 = lane & 31, hi = lane >> 5;
    LAS h16* Ks = (LAS h16*)lds;
    LAS h16* Vs = (LAS h16*)(lds + 36864);
    LAS h16* Os = (LAS h16*)(lds + 70144) + wave * (32 * 72);
    const int G = gridDim.x;
    int unit = blockIdx.x;
    if (unit >= 1024) return;
    unsigned m0 = 0;
#pragma unroll
    for (int r = 0; r < 16; ++r) if (crow(r, hi) > l31) m0 |= 1u << r;
    const int grow = lane >> 3, gcol = (lane & 7) * 8;
    h8 kvr[8];
#define ATT_LOADKV(U) do { const int kvh_ = (U) & 1, blk_ = ((U) >> 1) & 63, b_ = (U) >> 7; \
        _Pragma("unroll") for (int c_ = 0; c_ < 4; ++c_) { const int id = tid + 512 * c_, key = id >> 3, part = id & 7; const int l = blk_ * 128 - 128 + key; \
            kvr[c_] = (h8)(h16)0.f; if (l >= 0) kvr[c_] = *(const h8*)(k + ((size_t)b_ * SEQ + l) * 128 + kvh_ * 64 + part * 8); } \
        _Pragma("unroll") for (int c_ = 0; c_ < 4; ++c_) { const int id = tid + 512 * c_, key = id & 255, part = id >> 8; const int l = blk_ * 128 - 128 + key; \
            kvr[4 + c_] = (h8)(h16)0.f; if (l >= 0) kvr[4 + c_] = *(const h8*)(vt + ((size_t)b_ * SEQ + l) * 128 + kvh_ * 64 + part * 8); } } while (0)
#define ATT_STOREKV() do { \
        _Pragma("unroll") for (int c_ = 0; c_ < 4; ++c_) { const int id = tid + 512 * c_, key = id >> 3, part = id & 7; *(LAS h8*)(Ks + key * 72 + part * 8) = kvr[c_]; } \
        _Pragma("unroll") for (int c_ = 0; c_ < 4; ++c_) { const int id = tid + 512 * c_, key = id & 255, part = id >> 8; LAS h16* dst = Vs + (part * 8) * 260 + key; \
            _Pragma("unroll") for (int j_ = 0; j_ < 8; ++j_) dst[j_ * 260] = kvr[4 + c_][j_]; } } while (0)
#define ATT_LOADQ(U, I) do { const int kvh_ = (U) & 1, blk_ = ((U) >> 1) & 63, b_ = (U) >> 7; const h16* qp = q + ((size_t)b_ * SEQ + blk_ * 128 + 32 * (I) + l31) * DM + (kvh_ * 8 + wave) * 64 + 8 * hi; \
        _Pragma("unroll") for (int ds = 0; ds < 4; ++ds) qf[ds] = *(const h8*)(qp + 16 * ds); } while (0)
    h8 qf[4];
    ATT_LOADKV(unit);
    ATT_LOADQ(unit, 0);
    ATT_STOREKV();
    __syncthreads();
    for (;;) {
        const int kvh = unit & 1, blk = (unit >> 1) & 63, b = unit >> 7, hq = kvh * 8 + wave;
        const float sink2 = sinks[hq] * LOG2E;
        const int nunit = unit + G; const bool has_next = nunit < 1024;
#pragma unroll
        for (int i = 0; i < 4; ++i) {
            const size_t tok0 = (size_t)b * SEQ + blk * 128 + 32 * i;
            if (i == 3 && has_next) ATT_LOADKV(nunit);
            f32x16 s[5];
#pragma unroll
            for (int t5 = 0; t5 < 5; ++t5) { f32x16 a16;
#pragma unroll
                for (int r = 0; r < 16; ++r) a16[r] = 0.f;
#pragma unroll
                for (int ds = 0; ds < 4; ++ds) { const h8 kf = *(const LAS h8*)(Ks + (32 * (i + t5) + l31) * 72 + 16 * ds + 8 * hi); a16 = __builtin_amdgcn_mfma_f32_32x32x16_f16(kf, qf[ds], a16, 0, 0, 0); }
                s[t5] = a16; }
            h8 gt[4];
#pragma unroll
            for (int j = 0; j < 4; ++j) gt[j] = *(const h8*)(gate + (tok0 + grow + 8 * j) * DM + hq * 64 + gcol);
#pragma unroll
            for (int r = 0; r < 16; ++r) { const bool in0 = (m0 >> r) & 1u; s[0][r] = in0 ? s[0][r] : -1e30f; s[4][r] = in0 ? -1e30f : s[4][r]; }
            if (blk == 0) {
#pragma unroll
                for (int t5 = 0; t5 < 4; ++t5) if (i + t5 < 4) {
#pragma unroll
                    for (int r = 0; r < 16; ++r) s[t5][r] = -1e30f; }
            }
            float mx = sink2;
#pragma unroll
            for (int t5 = 0; t5 < 5; ++t5)
#pragma unroll
                for (int r = 0; r < 16; ++r) mx = fmaxf(mx, s[t5][r]);
            mx = fmaxf(mx, __shfl_xor(mx, 32));
            float sum = 0.f;
#pragma unroll
            for (int t5 = 0; t5 < 5; ++t5)
#pragma unroll
                for (int r = 0; r < 16; ++r) { const float p = __builtin_amdgcn_exp2f(s[t5][r] - mx); s[t5][r] = p; sum += p; }
            sum += __shfl_xor(sum, 32);
            sum += __builtin_amdgcn_exp2f(sink2 - mx);
            const float inv = __builtin_amdgcn_rcpf(sum);
            f32x16 o0, o1;
#pragma unroll
            for (int r = 0; r < 16; ++r) { o0[r] = 0.f; o1[r] = 0.f; }
#pragma unroll
            for (int t5 = 0; t5 < 5; ++t5)
#pragma unroll
                for (int ss = 0; ss < 2; ++ss) { h8 pf;
#pragma unroll
                    for (int j = 0; j < 8; ++j) pf[j] = (h16)(s[t5][8 * ss + j] * inv);
                    const int kb = 32 * (i + t5) + 16 * ss + 4 * hi;
                    { const LAS h16* vp = Vs + l31 * 260 + kb; const h4 lo = *(const LAS h4*)vp, hi4 = *(const LAS h4*)(vp + 8);
                      const h8 vf = __builtin_shufflevector(lo, hi4, 0, 1, 2, 3, 4, 5, 6, 7); o0 = __builtin_amdgcn_mfma_f32_32x32x16_f16(pf, vf, o0, 0, 0, 0); }
                    { const LAS h16* vp = Vs + (32 + l31) * 260 + kb; const h4 lo = *(const LAS h4*)vp, hi4 = *(const LAS h4*)(vp + 8);
                      const h8 vf = __builtin_shufflevector(lo, hi4, 0, 1, 2, 3, 4, 5, 6, 7); o1 = __builtin_amdgcn_mfma_f32_32x32x16_f16(pf, vf, o1, 0, 0, 0); } }
            if (i < 3) ATT_LOADQ(unit, i + 1); else if (has_next) ATT_LOADQ(nunit, 0);
#pragma unroll
            for (int r = 0; r < 16; ++r) { LAS h16* op = Os + crow(r, hi) * 72 + l31; op[0] = (h16)o0[r]; op[32] = (h16)o1[r]; }
#pragma unroll
            for (int j = 0; j < 4; ++j) { const h8 ov = *(const LAS h8*)(Os + (grow + 8 * j) * 72 + gcol); h8 res;
#pragma unroll
                for (int e = 0; e < 8; ++e) res[e] = (h16)((float)ov[e] * (float)gt[j][e]);
                *(h8*)(og + (tok0 + grow + 8 * j) * DM + hq * 64 + gcol) = res; }
        }
        if (!has_next) break;
        __syncthreads();
        ATT_STOREKV();
        __syncthreads();
        unit = nunit;
    }
#undef ATT_LOADKV
#undef ATT_STOREKV
#undef ATT_LOADQ
}

__device__ __forceinline__ void final_norm_phase(const PV& P, const int wave_s) {
    const int tid = get_tid(wave_s);
    const int lane = tid & 63, wave = tid >> 6; const int gw = blockIdx.x * 8 + wave, NGW = gridDim.x * 8;
    const float* ss = (const float*)(P.ws() + WS_SUMSQ) + (size_t)4 * M_TOK; const f32x4* gn = (const f32x4*)P.in(35);
    f32x4 gv[4];
#pragma unroll
    for (int j = 0; j < 4; ++j) gv[j] = gn[64 * j + lane];
    for (int row = gw; row < M_TOK; row += NGW) { const float rs = rsqrtf(ss[row] * (1.0f / DM) + NORM_EPS); f32x4* xr = (f32x4*)(P.out() + (size_t)row * DM) + lane;
#pragma unroll
        for (int j = 0; j < 4; ++j) { const f32x4 v = xr[64 * j]; xr[64 * j] = v * rs * gv[j]; } }
}


#define XB_TMO      128
#define XB_XCNT(j)  (256  + 64 * (j))
#define XB_XSUB(j)  (1280 + 64 * (j))
#define XB_XGEN(j)  (2304 + 64 * (j))
#define XB_TOP      3328
#define XB_TOPGEN   3392
#define XB_SPIN_CAP (1u << 22)
__device__ __forceinline__ unsigned xb_ld(unsigned* p)              { return __hip_atomic_load(p, __ATOMIC_RELAXED, __HIP_MEMORY_SCOPE_AGENT); }
__device__ __forceinline__ unsigned xb_add(unsigned* p, unsigned v) { return __hip_atomic_fetch_add(p, v, __ATOMIC_RELAXED, __HIP_MEMORY_SCOPE_AGENT); }
__device__ __forceinline__ unsigned xb_xcc_id() { return (unsigned)__builtin_amdgcn_s_getreg((3 << 11) | 20) & 0xFu; }
#define XB_SPIN(cond, bar) do { unsigned _sp = 0; while (cond) { __builtin_amdgcn_s_sleep(1); \
    if ((++_sp & 255u) == 0u) { if (xb_ld(&(bar)[XB_TMO])) break; if (_sp > XB_SPIN_CAP) { atomicAdd(&(bar)[XB_TMO], 1u); break; } } } } while (0)
struct XcdBarrier { unsigned* bar; unsigned x; volatile LAS unsigned* st; };
__device__ __forceinline__ XcdBarrier xcd_barrier_post(unsigned* bar, volatile LAS unsigned* st, int tid) {
    XcdBarrier b; b.bar = bar; b.x = xb_xcc_id(); b.st = st;
    if (tid == 0) (void)xb_add(&bar[XB_XCNT(b.x)], 1u);
    return b;
}
__device__ __forceinline__ void xcd_barrier_complete(unsigned* bar, unsigned x, unsigned& nloc, unsigned& nx) {
    const unsigned G = gridDim.x * gridDim.y * gridDim.z;
    unsigned sum, cnt, mine, sp = 0u;
    for (;;) {
        sum = 0u; cnt = 0u; mine = 0u;
#pragma unroll
        for (unsigned j = 0; j < 16; ++j) { const unsigned c = xb_ld(&bar[XB_XCNT(j)]); sum += c; cnt += (c > 0u) ? 1u : 0u; mine = (j == x) ? c : mine; }
        if (sum == G) break;
        __builtin_amdgcn_s_sleep(1);
        if ((++sp & 255u) == 0u) { if (xb_ld(&bar[XB_TMO])) break; if (sp > XB_SPIN_CAP) { atomicAdd(&bar[XB_TMO], 1u); break; } }
    }
    nloc = mine > 0u ? mine : 1u; nx = cnt > 0u ? cnt : 1u;
}
__device__ __forceinline__ void xcd_barrier(const XcdBarrier& b, int wave_s) {
    asm volatile("s_waitcnt vmcnt(0)" ::: "memory");
    __syncthreads();
    if (get_tid(wave_s) == 0) {
        unsigned* bar = b.bar;
        __builtin_amdgcn_s_waitcnt(0);
        unsigned nloc = b.st[0], nx = b.st[1];
        if (nloc == 0u) { xcd_barrier_complete(bar, b.x, nloc, nx); b.st[0] = nloc; b.st[1] = nx; }
        const unsigned old = xb_add(&bar[XB_XSUB(b.x)], 1u);
        const unsigned gen = old / nloc;
        if (old + 1u == (gen + 1u) * nloc) {
            __builtin_amdgcn_fence(__ATOMIC_RELEASE, "agent");
            asm volatile("s_waitcnt vmcnt(0)" ::: "memory");
            const unsigned og = xb_add(&bar[XB_TOP], 1u);
            const unsigned tg = og / nx;
            if (og + 1u == (tg + 1u) * nx) xb_add(&bar[XB_TOPGEN], 1u);
            else XB_SPIN(xb_ld(&bar[XB_TOPGEN]) == tg, bar);
            __builtin_amdgcn_fence(__ATOMIC_ACQUIRE, "agent");
            xb_add(&bar[XB_XGEN(b.x)], 1u);
            asm volatile("s_waitcnt vmcnt(0)" ::: "memory");
        } else {
            XB_SPIN(xb_ld(&bar[XB_XGEN(b.x)]) == gen, bar);
            __builtin_amdgcn_fence(__ATOMIC_ACQUIRE, "agent");
            asm volatile("s_waitcnt vmcnt(0)" ::: "memory");
        }
    }
    __syncthreads();
}

#ifndef PROBE_PHASE
#define PROBE_PHASE -1
#endif
#define PROBE_K 8
#define FUSE_FINAL 1
#define PROBE_LAYER_LO 0
#define PB(id) do { if (PROBE_PHASE == (id) && layer >= PROBE_LAYER_LO && layer < PROBE_LAYER_LO + 2) pt0 = __builtin_amdgcn_s_memrealtime(); } while (0)
#define SYNC(id) do { xcd_barrier(bar, wave_s); if (PROBE_PHASE == (id) && layer >= PROBE_LAYER_LO && layer < PROBE_LAYER_LO + 2 && blockIdx.x == 0) { const unsigned long long t1 = __builtin_amdgcn_s_memrealtime(); const unsigned long long dt = (t1 - pt0) * PROBE_K; \
    while (__builtin_amdgcn_s_memrealtime() - t1 < dt) __builtin_amdgcn_s_sleep(8); } } while (0)
constexpr int LDS_BYTES = 135168;
__global__ void __launch_bounds__(512) fwd_megakernel(Params KP) {
    LAS unsigned char* lds = (LAS unsigned char*)lds_raw;
    cg::grid_group grid = cg::this_grid();
    const int wave_s = __builtin_amdgcn_readfirstlane((int)(threadIdx.x >> 6));
    const int G = gridDim.x, c = blockIdx.x;
    volatile LAS unsigned* bst = (volatile LAS unsigned*)(lds + 131072);
    if (threadIdx.x < 2) bst[threadIdx.x] = 0u;
    volatile LAS unsigned long long* ptab = (volatile LAS unsigned long long*)(lds + 131072 + 16);
    if (threadIdx.x == 0) {
#pragma unroll
        for (int i = 0; i < 36; ++i) ptab[i] = (unsigned long long)KP.in[i];
        ptab[36] = (unsigned long long)KP.out; ptab[37] = (unsigned long long)KP.ws;
    }
    __syncthreads();
    const PV P{};
    const AGeo plainA{2048u, 32u, 128};

#ifndef PH_MASK
#define PH_MASK 0xFFFF
#endif
    unsigned long long pt0 = 0;
    if (PROBE_PHASE == 0) pt0 = __builtin_amdgcn_s_memrealtime();
    if (PH_MASK & 1) prep_phase(P, lds, wave_s);
    grid.sync();
    if (PROBE_PHASE == 0 && blockIdx.x == 0) { const unsigned long long t1 = __builtin_amdgcn_s_memrealtime(); const unsigned long long dt = (t1 - pt0) * PROBE_K; while (__builtin_amdgcn_s_memrealtime() - t1 < dt) __builtin_amdgcn_s_sleep(8); }
    const XcdBarrier bar = xcd_barrier_post((unsigned*)(P.ws() + WS_BAR), bst, get_tid(wave_s));

#pragma unroll 1
    for (int layer = 0; layer < 4; ++layer) {
        unsigned char* ws = P.ws();
        float* sumsq = (float*)(ws + WS_SUMSQ);
        h16* xh = (h16*)(ws + WS_XH); h16* UH = (h16*)(ws + WS_UH); float* Gp = (float*)(ws + WS_GP); h16* gate = (h16*)(ws + WS_GATE);
        h16* Zg = (h16*)(ws + WS_ZG); h16* og = (h16*)(ws + WS_OG);
        if ((layer & 1) == 0) {
            const int L = layer >> 1;
            const unsigned char* win = ws + (L ? W_IN2 : W_IN0); const unsigned char* wglu = ws + (L ? W_GLU2 : W_GLU0); const unsigned char* wout = ws + (L ? W_OUT2 : W_OUT0);
            const float* bglu = P.in(L ? 29 : 12);
            { PlainOrder S; S.init(M_TOK, 2048, G, c, xh, (size_t)256 * 2048, win, (size_t)256 * 2048);
              EpiG1Ssm E{sumsq + (size_t)layer * M_TOK, UH, gate};
              PB(1); if (PH_MASK & 2) gemm_phase(lds, wave_s, plainA, 2048u, S, E); }
            SYNC(1);
            { GroupOrderS1 S{G, c, (const char*)(UH + 128), (const char*)(ws + WS_BT1) + (size_t)L * 64 * 256 * 512 * 2, (size_t)ROWS_G * UHK * 2, (size_t)256 * 512 * 2, (size_t)256 * UHK * 2};
              EpiS1 E{Gp};
              PB(2); if (PH_MASK & 4) gemm_phase(lds, wave_s, AGeo{UHK * 2u, 32u, 128}, 1024u, S, E); }
            SYNC(2);
            PB(3); if (PH_MASK & 8) s2_phase(P, L, lds, wave_s);
            SYNC(3);
            { GroupOrderS3 S{G, c, (const char*)UH, (const char*)(ws + WS_BT3) + (size_t)L * 64 * 512 * 640 * 2, (size_t)ROWS_G * UHK * 2, (size_t)512 * 640 * 2, (size_t)256 * UHK * 2, (size_t)256 * 640 * 2};
              EpiS3 E{(const float*)(ws + WS_STEP) + L * 64, Zg};
              PB(4); if (PH_MASK & 16) gemm_phase(lds, wave_s, AGeo{UHK * 2u, 32u, 128}, 1280u, S, E); }
            SYNC(4);
            { PlainOrder S; S.init(M_TOK, 1024, G, c, Zg, (size_t)256 * 32, wglu, (size_t)256 * 2048);
              EpiGlu E{Zg, gate, bglu, og};
              PB(5); if (PH_MASK & 32) gemm_phase(lds, wave_s, AGeo{32u, (unsigned)(M_TOK * 32), (size_t)4 * M_TOK * 32}, 2048u, S, E); }
            SYNC(5);
            { PlainOrder S; S.init(M_TOK, 1024, G, c, og, (size_t)256 * 2048, wout, (size_t)256 * 2048);
              EpiOut E{xh, sumsq + (size_t)(layer + 1) * M_TOK};
              PB(6); if (PH_MASK & 64) gemm_phase(lds, wave_s, plainA, 2048u, S, E); }
            SYNC(6);
        } else {
            const unsigned char* win = ws + (layer == 1 ? W_IN1 : W_IN3); const unsigned char* wout = ws + (layer == 1 ? W_OUT1 : W_OUT3);
            { PlainOrder S; S.init(M_TOK, 2304, G, c, xh, (size_t)256 * 2048, win, (size_t)256 * 2048);
              EpiG1Att E{sumsq + (size_t)layer * M_TOK, (const f32x2*)(ws + WS_ROPE), (h16*)(ws + WS_UH), (h16*)(ws + WS_K), (h16*)(ws + WS_VT), gate};
              PB(7); if (PH_MASK & 128) gemm_phase(lds, wave_s, plainA, 2048u, S, E); }
            SYNC(7);
            PB(8); if (PH_MASK & 256) attn_phase(P, layer, lds, wave_s);
            SYNC(8);
            { PlainOrder S; S.init(M_TOK, 1024, G, c, og, (size_t)256 * 2048, wout, (size_t)256 * 2048);
              if (layer == 1) { EpiOut E{xh, sumsq + (size_t)(layer + 1) * M_TOK};
                PB(9); if (PH_MASK & 512) gemm_phase(lds, wave_s, plainA, 2048u, S, E); }
              else if (G == 256 && FUSE_FINAL) { EpiOutFinal E{xh, P.out(), sumsq + (size_t)4 * M_TOK, (unsigned*)(ws + WS_CNT), P.in(35)};
                if (PROBE_PHASE == 11) pt0 = __builtin_amdgcn_s_memrealtime();
                gemm_phase(lds, wave_s, plainA, 2048u, S, E);
                if (PROBE_PHASE == 11 && blockIdx.x == 0) { const unsigned long long t1 = __builtin_amdgcn_s_memrealtime(); const unsigned long long dt = (t1 - pt0) * PROBE_K; while (__builtin_amdgcn_s_memrealtime() - t1 < dt) __builtin_amdgcn_s_sleep(8); } }
              else { EpiOutLast E{xh, P.out(), sumsq + (size_t)4 * M_TOK};
                gemm_phase(lds, wave_s, plainA, 2048u, S, E); } }
            if (!(layer == 3 && G == 256 && FUSE_FINAL)) SYNC(9);
        }
    }
    { const int layer = 0; PB(10); if ((PH_MASK & 1024) && !(G == 256 && FUSE_FINAL)) final_norm_phase(P, wave_s);
      if (PROBE_PHASE == 10 && blockIdx.x == 0) { const unsigned long long t1 = __builtin_amdgcn_s_memrealtime(); const unsigned long long dt = (t1 - pt0) * PROBE_K; while (__builtin_amdgcn_s_memrealtime() - t1 < dt) __builtin_amdgcn_s_sleep(8); } }
}

extern "C" void kernel_launch(void* const* d_in, const int* in_sizes, int n_in, void* d_out, int out_size, void* d_ws, size_t ws_size, hipStream_t stream) {
    static int grid_blocks = 0;
    if (grid_blocks == 0) {
        if (n_in != 36 || ws_size < WS_END) { fprintf(stderr, "kernel_launch: unexpected n_in %d / ws %zu\n", n_in, ws_size); grid_blocks = -1; return; }
        int dev = 0, cus = 0, per_cu = 0;
        hipGetDevice(&dev);
        hipDeviceGetAttribute(&cus, hipDeviceAttributeMultiprocessorCount, dev);
        hipFuncSetAttribute((const void*)fwd_megakernel, hipFuncAttributeMaxDynamicSharedMemorySize, LDS_BYTES);
        hipOccupancyMaxActiveBlocksPerMultiprocessor(&per_cu, (const void*)fwd_megakernel, 512, LDS_BYTES);
        if (per_cu < 1) per_cu = 1;
        grid_blocks = cus * per_cu;
        (void)hipGetLastError();
    }
    if (grid_blocks < 0) return;
    Params p{};
    for (int i = 0; i < 36; ++i) p.in[i] = (const float*)d_in[i];
    p.out = (float*)d_out; p.ws = (unsigned char*)d_ws;
    void* args[] = {&p};
    hipError_t e = hipLaunchCooperativeKernel((const void*)fwd_megakernel, dim3(grid_blocks), dim3(512), args, LDS_BYTES, stream);
    if (e != hipSuccess) fprintf(stderr, "cooperative launch failed: %s (grid %d)\n", hipGetErrorString(e), grid_blocks);
}
```
